# Optimizing an MI355X kernel written in HIP

```python
import jax, jax.numpy as jnp
from jax import lax
import numpy as np

D_MODEL = 1024
BATCH = 2
SEQ = 16384
DEPTH = 1
DEC_BATCH = 8
DEC_SEQ = 16
PAST_LEN = 4096

CHUNK = 64
N_PREV_CHUNKS = 8
ATT_WINDOW = N_PREV_CHUNKS * CHUNK
N_HEADS_A = 8
HEAD_DIM_A = 64
D_A = N_HEADS_A * HEAD_DIM_A
REL_CLIP = 128
N_REL = CHUNK + REL_CLIP
N_HEADS_B = 4
HEAD_K_B = 128
HEAD_V_B = 128
D_B = N_HEADS_B * HEAD_K_B
D_B_V = N_HEADS_B * HEAD_V_B
D_FF = 2816
CONV_W = 3
EPS = 1e-6
IN_SPLITS = (D_A, D_A, D_A, D_B, D_B, D_B_V, D_B_V, D_MODEL, D_MODEL)
D_IN = sum(IN_SPLITS)

kernel_name = "hybrid_chunk_attn_hgrn2_convffn_step"


def rms_norm(x, g):
    xf = x.astype(jnp.float32)
    y = xf * lax.rsqrt(jnp.mean(xf * xf, axis=-1, keepdims=True) + EPS)
    return (y * g.astype(jnp.float32)).astype(x.dtype)


def split_in(h, w_in):
    z = h @ w_in
    offs = [int(o) for o in np.cumsum(IN_SPLITS)[:-1]]
    return jnp.split(z, offs, axis=-1)


def rel_bias_mask(qpos, kpos, table):
    d = qpos[..., :, None] - kpos[..., None, :]
    idx = jnp.clip(d, -(CHUNK - 1), REL_CLIP) + (CHUNK - 1)
    bias = jnp.moveaxis(table[:, idx], 0, -3)
    qc = (qpos // CHUNK)[..., :, None]
    kc = (kpos // CHUNK)[..., None, :]
    valid = (kpos[..., None, :] >= 0) & (kc <= qc) & (kc >= qc - N_PREV_CHUNKS)
    return bias, valid[..., None, :, :]


def band_attention(q, k, v, bias, valid):
    s = jnp.einsum('...hqd,...hkd->...hqk', q, k).astype(jnp.float32) * (HEAD_DIM_A ** -0.5)
    s = jnp.where(valid, s + bias.astype(jnp.float32), -jnp.inf)
    p = jax.nn.softmax(s, axis=-1).astype(v.dtype)
    return jnp.einsum('...hqk,...hkd->...hqd', p, v)


def attn_prompt(qa, ka, va, table):
    B, L, _ = qa.shape
    nC = L // CHUNK
    def to_chunks(t):
        return t.reshape(B, nC, CHUNK, N_HEADS_A, HEAD_DIM_A).transpose(0, 1, 3, 2, 4)
    qc, kc, vc = to_chunks(qa), to_chunks(ka), to_chunks(va)
    pad = ((0, 0), (N_PREV_CHUNKS, 0), (0, 0), (0, 0), (0, 0))
    kp, vp = jnp.pad(kc, pad), jnp.pad(vc, pad)
    kb = jnp.concatenate([kp[:, j:j + nC] for j in range(N_PREV_CHUNKS + 1)], axis=3)
    vb = jnp.concatenate([vp[:, j:j + nC] for j in range(N_PREV_CHUNKS + 1)], axis=3)
    qpos = jnp.arange(L).reshape(nC, CHUNK)
    kpos = (jnp.arange(nC)[:, None] - N_PREV_CHUNKS) * CHUNK + jnp.arange((N_PREV_CHUNKS + 1) * CHUNK)[None, :]
    bias, valid = rel_bias_mask(qpos, kpos, table)
    o = band_attention(qc, kb, vb, bias, valid)
    o = o.transpose(0, 1, 3, 2, 4).reshape(B, L, D_A)
    w = min(ATT_WINDOW, L)
    def last_rows(t):
        return t.reshape(B, L, N_HEADS_A, HEAD_DIM_A)[:, L - w:].transpose(0, 2, 1, 3)
    return o, last_rows(ka), last_rows(va)


def attn_sample(qa, ka, va, cache_k, cache_v, table):
    B, L, _ = qa.shape
    def heads(t):
        return t.reshape(B, L, N_HEADS_A, HEAD_DIM_A).transpose(0, 2, 1, 3)
    q, k, v = heads(qa), heads(ka), heads(va)
    kk = jnp.concatenate([cache_k.astype(k.dtype), k], axis=2)
    vv = jnp.concatenate([cache_v.astype(v.dtype), v], axis=2)
    w = cache_k.shape[2]
    qpos = PAST_LEN + jnp.arange(L)
    kpos = jnp.concatenate([PAST_LEN - w + jnp.arange(w), qpos])
    bias, valid = rel_bias_mask(qpos, kpos, table)
    o = band_attention(q, kk, vv, bias, valid)
    return o.transpose(0, 2, 1, 3).reshape(B, L, D_A), k, v


def hgrn2_prep(qb, fb, ib, lb):
    B, L, _ = qb.shape
    f = lb + (1.0 - lb) * jax.nn.sigmoid(fb.astype(jnp.float32))
    q = jax.nn.silu(qb.astype(jnp.float32))
    k = 1.0 - f
    logf = jnp.log(f)
    hk = lambda t: t.reshape(B, L, N_HEADS_B, HEAD_K_B)
    v = ib.astype(jnp.float32).reshape(B, L, N_HEADS_B, HEAD_V_B)
    return hk(q), hk(k), v, hk(logf)


def hgrn2_scan(q, k, v, logf, S0, block):
    B, L = q.shape[:2]
    n = L // block
    def blocks(t):
        return t.reshape(B, n, block, t.shape[2], t.shape[3]).transpose(1, 0, 3, 2, 4)
    tri = jnp.tril(jnp.ones((block, block), dtype=bool))
    def step(S, inp):
        qc, kc, vc, gc = inp
        b = jnp.cumsum(gc, axis=2)
        inter = jnp.einsum('bhtk,bhkv->bhtv', qc * jnp.exp(b), S)
        diff = b[:, :, :, None, :] - b[:, :, None, :, :]
        decay = jnp.exp(jnp.where(tri[:, :, None], diff, -jnp.inf))
        A = jnp.einsum('bhtk,bhsk,bhtsk->bhts', qc, kc, decay)
        intra = jnp.einsum('bhts,bhsv->bhtv', A, vc)
        bC = b[:, :, -1:, :]
        S_new = jnp.exp(bC[:, :, 0, :])[..., None] * S + jnp.einsum('bhsk,bhsv->bhkv', kc * jnp.exp(bC - b), vc)
        return S_new, inter + intra
    S_fin, o = lax.scan(step, S0.astype(jnp.float32), (blocks(q), blocks(k), blocks(v), blocks(logf)))
    o = o.transpose(1, 0, 3, 2, 4).reshape(B, L, N_HEADS_B, HEAD_V_B)
    return o, S_fin


def hgrn2_out(o, gb, g_norm):
    B, L = o.shape[:2]
    on = o * lax.rsqrt(jnp.mean(o * o, axis=-1, keepdims=True) + EPS) * g_norm.astype(jnp.float32)
    return on.reshape(B, L, D_B_V) * jax.nn.silu(gb.astype(jnp.float32))


def conv_ffn(h, prev, w_gate, w_up, conv_w, conv_b, w_down):
    a = h @ w_gate
    L = a.shape[1]
    ap = jnp.concatenate([prev.astype(a.dtype), a], axis=1)
    ac = conv_b
    for j in range(CONV_W):
        ac = ac + conv_w[j] * ap[:, j:j + L]
    y = (jax.nn.gelu(ac) * (h @ w_up)) @ w_down
    return y, ap[:, ap.shape[1] - (CONV_W - 1):]


def layer(x, lb, cache_k, cache_v, S0, conv_prev, block, norm_mix_g, w_in, rel_bias, hgrn_norm_g,
          w_branch_a, w_branch_b, w_out, norm_ffn_g, w_ffn_gate, w_ffn_up, ffn_conv_w, ffn_conv_b, w_ffn_down):
    h = rms_norm(x, norm_mix_g)
    qa, ka, va, qb, fb, ib, gb, za, zb = split_in(h, w_in)
    if cache_k is None:
        oa, k_rows, v_rows = attn_prompt(qa, ka, va, rel_bias)
    else:
        oa, k_rows, v_rows = attn_sample(qa, ka, va, cache_k, cache_v, rel_bias)
    q, k, v, logf = hgrn2_prep(qb, fb, ib, lb)
    ob, S_new = hgrn2_scan(q, k, v, logf, S0, block)
    ob = hgrn2_out(ob, gb, hgrn_norm_g).astype(x.dtype)
    merged = jax.nn.sigmoid(za) * (oa @ w_branch_a) + jax.nn.sigmoid(zb) * (ob @ w_branch_b)
    x = x + merged @ w_out
    y, conv_new = conv_ffn(rms_norm(x, norm_ffn_g), conv_prev, w_ffn_gate, w_ffn_up, ffn_conv_w, ffn_conv_b, w_ffn_down)
    return x + y, k_rows, v_rows, S_new, conv_new


def setup_inputs(seed: int = 0) -> dict:
    key = jax.random.key(seed)
    ks = jax.random.split(key, 24)
    nrm = lambda i, shape, s=1.0: jax.random.normal(ks[i], shape, jnp.float32) * s
    w_att = min(ATT_WINDOW, PAST_LEN)
    return {
        "x_prompt": nrm(0, (BATCH, SEQ, D_MODEL)),
        "x_sample": nrm(1, (DEC_BATCH, DEC_SEQ, D_MODEL)),
        "cache_attn_k": nrm(2, (DEPTH, DEC_BATCH, N_HEADS_A, w_att, HEAD_DIM_A)),
        "cache_attn_v": nrm(3, (DEPTH, DEC_BATCH, N_HEADS_A, w_att, HEAD_DIM_A)),
        "state_hgrn": nrm(4, (DEPTH, DEC_BATCH, N_HEADS_B, HEAD_K_B, HEAD_V_B)),
        "state_ffn_conv": nrm(5, (DEPTH, DEC_BATCH, CONV_W - 1, D_FF)),
        "norm_mix_g": 1.0 + nrm(6, (DEPTH, D_MODEL), 0.05),
        "w_in": nrm(7, (DEPTH, D_MODEL, D_IN), D_MODEL ** -0.5),
        "rel_bias": nrm(8, (DEPTH, N_HEADS_A, N_REL), 0.5),
        "hgrn_lb_logits": nrm(9, (DEPTH + 1, D_B)),
        "hgrn_norm_g": 1.0 + nrm(10, (DEPTH, HEAD_V_B), 0.05),
        "w_branch_a": nrm(11, (DEPTH, D_A, D_MODEL), D_A ** -0.5),
        "w_branch_b": nrm(12, (DEPTH, D_B_V, D_MODEL), D_B_V ** -0.5),
        "w_out": nrm(13, (DEPTH, D_MODEL, D_MODEL), D_MODEL ** -0.5),
        "norm_ffn_g": 1.0 + nrm(14, (DEPTH, D_MODEL), 0.05),
        "w_ffn_gate": nrm(15, (DEPTH, D_MODEL, D_FF), D_MODEL ** -0.5),
        "w_ffn_up": nrm(16, (DEPTH, D_MODEL, D_FF), D_MODEL ** -0.5),
        "ffn_conv_w": nrm(17, (DEPTH, CONV_W, D_FF), CONV_W ** -0.5),
        "ffn_conv_b": nrm(18, (DEPTH, D_FF), 0.01),
        "w_ffn_down": nrm(19, (DEPTH, D_FF, D_MODEL), D_FF ** -0.5),
        "norm_final_g": 1.0 + nrm(20, (D_MODEL,), 0.05),
    }


def reference(x_prompt, x_sample, cache_attn_k, cache_attn_v, state_hgrn, state_ffn_conv,
              norm_mix_g, w_in, rel_bias, hgrn_lb_logits, hgrn_norm_g, w_branch_a, w_branch_b, w_out,
              norm_ffn_g, w_ffn_gate, w_ffn_up, ffn_conv_w, ffn_conv_b, w_ffn_down, norm_final_g):
    lbs = jnp.cumsum(jax.nn.softmax(hgrn_lb_logits.astype(jnp.float32), axis=0), axis=0)
    xp, xs = x_prompt, x_sample
    Bp, Bs = x_prompt.shape[0], x_sample.shape[0]
    kp_l, vp_l, sp_l, cp_l, ks_l, vs_l, ss_l, cs_l = [], [], [], [], [], [], [], []
    for l in range(DEPTH):
        w = (norm_mix_g[l], w_in[l], rel_bias[l], hgrn_norm_g[l], w_branch_a[l], w_branch_b[l], w_out[l],
             norm_ffn_g[l], w_ffn_gate[l], w_ffn_up[l], ffn_conv_w[l], ffn_conv_b[l], w_ffn_down[l])
        S0p = jnp.zeros((Bp, N_HEADS_B, HEAD_K_B, HEAD_V_B), jnp.float32)
        conv0 = jnp.zeros((Bp, CONV_W - 1, D_FF), xp.dtype)
        xp, kr, vr, Sp, cp = layer(xp, lbs[l], None, None, S0p, conv0, CHUNK, *w)
        kp_l.append(kr); vp_l.append(vr); sp_l.append(Sp.astype(xp.dtype)); cp_l.append(cp)
        xs, kr, vr, Ss, cs = layer(xs, lbs[l], cache_attn_k[l], cache_attn_v[l], state_hgrn[l],
                                   state_ffn_conv[l], xs.shape[1], *w)
        ks_l.append(kr); vs_l.append(vr); ss_l.append(Ss.astype(state_hgrn.dtype)); cs_l.append(cs)
    y_prompt = rms_norm(xp, norm_final_g)
    y_sample = rms_norm(xs, norm_final_g)
    return (y_prompt, y_sample,
            jnp.stack(kp_l), jnp.stack(vp_l), jnp.stack(sp_l), jnp.stack(cp_l),
            jnp.stack(ks_l), jnp.stack(vs_l), jnp.stack(ss_l), jnp.stack(cs_l))
```

```cpp
#include <hip/hip_runtime.h>
#include <cstdio>
#include <cstdint>

#ifndef MK_N_LAUNCHES
#define MK_N_LAUNCHES 1
#endif

constexpr int DM = 1024, NBATCH = 2, SEQ = 16384, DBATCH = 8, DSEQ = 16, PAST = 4096;
constexpr int MP = NBATCH * SEQ;
constexpr int MS = DBATCH * DSEQ;
constexpr int MV = MP + MS;
constexpr int MPAD = 33024;
constexpr int DIN = 5632, DFF = 2816, DA = 512;
constexpr int NHA = 8, NHB = 4;
constexpr int NREL = 192;
constexpr float EPS = 1e-6f;
constexpr float LOG2E = 1.4426950408889634f;
constexpr float LN2 = 0.6931471805599453f;
constexpr float QSCALE = 0.125f * LOG2E;

constexpr size_t O_Y = 0, O_KP = 33685504, O_VP = 34209792, O_HP = 34734080, O_CP = 34865152, O_KS = 34876416, O_VS = 34941952, O_HS = 35007488, O_CS = 35531776, O_END = 35576832;

constexpr size_t MiB = 1u << 20;
constexpr size_t WS_CTL = 0, CTL_ZERO_BYTES = 1 * MiB;
constexpr size_t WS_WIN = 2 * MiB, WS_WA = 13 * MiB, WS_WB = 14 * MiB, WS_WOUT = 15 * MiB, WS_WGU = 17 * MiB, WS_WD = 28 * MiB;
constexpr size_t WS_RS1 = 34 * MiB, WS_RS2 = 37 * MiB;
constexpr size_t SZ_R512 = (size_t)MPAD * 512 * 2, SZ_R1024 = (size_t)MPAD * 1024 * 2;
constexpr size_t WS_H = 40 * MiB;
constexpr size_t WS_QA = 105 * MiB, WS_KA = WS_QA + SZ_R512, WS_VA = WS_KA + SZ_R512, WS_QB = WS_VA + SZ_R512, WS_VB = WS_QB + SZ_R512, WS_GB = WS_VB + SZ_R512;
constexpr size_t WS_LF = WS_GB + SZ_R512;
constexpr size_t WS_ZA = WS_LF + SZ_R1024, WS_ZB = WS_ZA + SZ_R1024;
constexpr size_t WS_DC = WS_ZB + SZ_R1024;
constexpr size_t WS_END = WS_DC + 1 * MiB;
constexpr size_t WS_MG = WS_KA;
constexpr size_t WS_X1B = WS_H;
constexpr size_t WS_US = WS_H;
constexpr size_t SZ_FF = (size_t)MPAD * DFF * 2;
constexpr size_t WS_AB = WS_QA, WS_UB = WS_AB + SZ_FF;
static_assert(WS_UB + SZ_FF <= WS_DC && WS_END <= 512 * MiB, "d_ws map");

constexpr int CW_TMO = 0, CW_BAR = 4096;

constexpr int RING_BYTES = 131072, LDSCTL_OFF = RING_BYTES, MISC_OFF = LDSCTL_OFF + 320, LDS_BYTES = 147456;
constexpr int NWAVES = 8;

#define GAS __attribute__((address_space(1)))
#define LAS __attribute__((address_space(3)))
typedef unsigned short bf16;
typedef unsigned v4u __attribute__((ext_vector_type(4)));
typedef float f32x4 __attribute__((ext_vector_type(4)));
typedef float f32x2 __attribute__((ext_vector_type(2)));
typedef __bf16 bf16x2_t __attribute__((ext_vector_type(2)));
typedef short bf16x8 __attribute__((ext_vector_type(8)));
typedef GAS unsigned gu32;
#define RLX_AGENT __ATOMIC_RELAXED, __HIP_MEMORY_SCOPE_AGENT
#define LDS_WAIT() asm volatile("s_waitcnt lgkmcnt(0)" ::: "memory")
#define VM_WAIT() asm volatile("s_waitcnt vmcnt(0)" ::: "memory")

__device__ __forceinline__ unsigned pk2(float lo, float hi) { f32x2 v = {lo, hi}; bf16x2_t b = __builtin_convertvector(v, bf16x2_t); return __builtin_bit_cast(unsigned, b); }
__device__ __forceinline__ float bf2f(unsigned short x) { return __uint_as_float((unsigned)x << 16); }
__device__ __forceinline__ float bflo(unsigned w) { return __uint_as_float(w << 16); }
__device__ __forceinline__ float bfhi(unsigned w) { return __uint_as_float(w & 0xffff0000u); }
__device__ __forceinline__ float fast_sigmoid(float x) { return __builtin_amdgcn_rcpf(1.0f + __builtin_amdgcn_exp2f(-x * LOG2E)); }
__device__ __forceinline__ float fast_exp(float x) { return __builtin_amdgcn_exp2f(x * LOG2E); }

namespace pg8 {
#define PG8_LAS __attribute__((address_space(3)))
typedef unsigned short bf16_t;
constexpr int BM = 256, BK = 64, HALF = 128, HTB = HALF * BK * 2, STAGE_BYTES = 8 * HTB, NXCD = 8, WGM = 8;
__host__ __device__ __forceinline__ int lds_byte(int r, int c) { const int st = (r >> 4) * 2 + (c >> 5), rr = r & 15, cc = c & 31, ob = rr * 64 + cc * 2; return st * 1024 + (ob ^ (((ob >> 9) & 1) << 5)); }
__host__ __device__ __forceinline__ void stage_rc(int b, int& R, int& C) { const int st = b / 1024, sb = b % 1024, swz = sb ^ (((sb >> 9) & 1) << 5); R = (st >> 1) * 16 + swz / 64; C = (st & 1) * 32 + (swz % 64) / 2; }
__host__ __device__ __forceinline__ int perm32(int rho) { const int n = rho >> 4, i = rho & 15; return 8 * (i >> 2) + 4 * n + (i & 3); }

struct Unit { const char* a; const char* b; int pm, pn, kind; };

struct TileOrder {
    int nM, nN, nwg;
    __device__ __forceinline__ void init(int nM_, int nN_) { nM = nM_; nN = nN_; nwg = nM * nN; }
    __device__ __forceinline__ bool tile(long L, int& pm, int& pn) const {
        if (L >= nwg) return false;
        int wgid = (int)L; { const int q = nwg / NXCD, r = nwg % NXCD, xcd = wgid % NXCD, off = wgid / NXCD; wgid = (xcd < r ? xcd * (q + 1) : r * (q + 1) + (xcd - r) * q) + off; }
        const int nig = WGM * nN, gid = wgid / nig, fm = gid * WGM, gsz = (nM - fm) < WGM ? (nM - fm) : WGM;
        pm = fm + ((wgid % nig) % gsz); pn = (wgid % nig) / gsz; return true;
    }
};

template <class Epi, class Sched>
__device__ __forceinline__ void gemm_phase(PG8_LAS unsigned char* lds, const int K, const Sched& S, const Epi& E) {
    const int tid = threadIdx.x, wid = __builtin_amdgcn_readfirstlane(tid >> 6), lane = tid & 63, wr = wid >> 2, wc = wid & 3, fr = lane & 15, fq = lane >> 4;
    const int nt = K / BK;
    unsigned voffA[2], voffB[2];
#pragma unroll
    for (int i = 0; i < 2; ++i) { int R, C; stage_rc(tid * 16 + i * 8192, R, C); const int Rb = (R & ~31) + perm32(R & 31);
        voffA[i] = (unsigned)(R * K + C) * 2u; voffB[i] = (unsigned)(Rb * K + C) * 2u; }
    const size_t kstep = (size_t)(BK * 2);
    const size_t hstep = (size_t)HALF * K * 2;
    const unsigned ldsw = (unsigned)wid * 1024u;
    const int aoff = lds_byte(wr * 64 + fr, fq * 8), boff = lds_byte(wc * 32 + fr, fq * 8);
#define PG8_SA(b, h) (((b) * 2 + (h)) * HTB)
#define PG8_SB(b, h) ((4 + (b) * 2 + (h)) * HTB)
#define PG8_STAGE(bufoff, gbase, voff) do { _Pragma("unroll") for (int _i = 0; _i < 2; ++_i) \
        __builtin_amdgcn_global_load_lds((const unsigned*)((const char*)(gbase) + (voff)[_i]), (PG8_LAS unsigned*)(lds + (bufoff) + ldsw + _i * 8192), 16, 0, 0); } while (0)
#define PG8_LDA(dst, b, h) do { _Pragma("unroll") for (int m = 0; m < 4; ++m) _Pragma("unroll") for (int k = 0; k < 2; ++k) dst[m][k] = *(const PG8_LAS bf16x8*)(lds + PG8_SA(b, h) + aoff + m * 2048 + k * 1024); } while (0)
#define PG8_LDB(dst, b, h) do { _Pragma("unroll") for (int n = 0; n < 2; ++n) _Pragma("unroll") for (int k = 0; k < 2; ++k) dst[n][k] = *(const PG8_LAS bf16x8*)(lds + PG8_SB(b, h) + boff + n * 2048 + k * 1024); } while (0)
#define PG8_MMA(ai, bj, At, Bt) do { __builtin_amdgcn_s_setprio(1); _Pragma("unroll") for (int m = 0; m < 4; ++m) _Pragma("unroll") for (int n = 0; n < 2; ++n) _Pragma("unroll") for (int k = 0; k < 2; ++k) \
        acc[ai][bj][m][n] = __builtin_amdgcn_mfma_f32_16x16x32_bf16(Bt[n][k], At[m][k], acc[ai][bj][m][n], 0, 0, 0); __builtin_amdgcn_s_setprio(0); } while (0)
#define PG8_WAIT_V(n) asm volatile("s_waitcnt vmcnt(" #n ")" ::: "memory")
#define PG8_WAIT_L(n) asm volatile("s_waitcnt lgkmcnt(" #n ")" ::: "memory")
#define PG8_BAR __builtin_amdgcn_s_barrier()
#define PG8_SCHED __builtin_amdgcn_sched_barrier(0)
    Unit cur, nxt; int ui = 0;
    if (!S.next(0, cur)) return;
    f32x4 acc[2][2][4][2];
#pragma unroll
    for (int a = 0; a < 2; ++a)
#pragma unroll
        for (int b = 0; b < 2; ++b)
#pragma unroll
            for (int m = 0; m < 4; ++m)
#pragma unroll
                for (int n = 0; n < 2; ++n) acc[a][b][m][n] = (f32x4){0.f, 0.f, 0.f, 0.f};
    bf16x8 At[4][2], B0[2][2], B1[2][2];
    const char* cA = cur.a; const char* cB = cur.b;
    PG8_STAGE(PG8_SB(0, 0), cB, voffB); PG8_STAGE(PG8_SB(0, 1), cB + hstep, voffB); PG8_STAGE(PG8_SA(0, 0), cA, voffA); PG8_STAGE(PG8_SA(0, 1), cA + hstep, voffA);
    if (wr == 1) PG8_BAR;
    PG8_WAIT_V(2); PG8_BAR;
    PG8_STAGE(PG8_SB(1, 0), cB + kstep, voffB); PG8_STAGE(PG8_SA(1, 0), cA + kstep, voffA); PG8_STAGE(PG8_SB(1, 1), cB + hstep + kstep, voffB);
    PG8_WAIT_V(6); PG8_BAR;
    for (;;) {
        const bool has_next = S.next(ui + 1, nxt);
        const char* nA = has_next ? nxt.a : cA; const char* nB = has_next ? nxt.b : cB;
        for (int t = 0; t < nt; t += 2) {
            const bool last = (t == nt - 2);
            const char* a1 = cA + (size_t)(t + 1) * kstep;
            const char* a2 = last ? nA : cA + (size_t)(t + 2) * kstep; const char* b2 = last ? nB : cB + (size_t)(t + 2) * kstep;
            const char* a3 = a2 + kstep; const char* b3 = b2 + kstep;
            PG8_LDB(B0, 0, 0); PG8_LDB(B1, 0, 1); PG8_SCHED; PG8_LDA(At, 0, 0); PG8_STAGE(PG8_SA(1, 1), a1 + hstep, voffA);
            PG8_WAIT_V(8); PG8_WAIT_L(0); PG8_BAR; PG8_MMA(0, 0, At, B0); PG8_MMA(0, 1, At, B1); PG8_BAR; PG8_SCHED;
            PG8_LDA(At, 0, 1); PG8_STAGE(PG8_SB(0, 0), b2, voffB); PG8_STAGE(PG8_SB(0, 1), b2 + hstep, voffB); PG8_STAGE(PG8_SA(0, 0), a2, voffA);
            PG8_WAIT_V(8); PG8_WAIT_L(0); PG8_BAR; PG8_MMA(1, 0, At, B0); PG8_MMA(1, 1, At, B1); PG8_BAR; PG8_SCHED;
            PG8_LDB(B0, 1, 0); PG8_LDB(B1, 1, 1); PG8_SCHED; PG8_LDA(At, 1, 0); PG8_STAGE(PG8_SA(0, 1), a2 + hstep, voffA);
            PG8_WAIT_V(8); PG8_WAIT_L(0); PG8_BAR; PG8_MMA(0, 0, At, B0); PG8_MMA(0, 1, At, B1); PG8_BAR; PG8_SCHED;
            PG8_LDA(At, 1, 1); PG8_STAGE(PG8_SB(1, 0), b3, voffB); PG8_STAGE(PG8_SB(1, 1), b3 + hstep, voffB); PG8_STAGE(PG8_SA(1, 0), a3, voffA);
            PG8_WAIT_V(8); PG8_WAIT_L(0); PG8_BAR; PG8_MMA(1, 0, At, B0); PG8_MMA(1, 1, At, B1); PG8_BAR; PG8_SCHED;
        }
        if (wr == 0) PG8_BAR;
        E(acc, cur, wr, wc, fr, fq);
        if (!has_next) break;
        if (!E.keep(cur)) {
#pragma unroll
        for (int a = 0; a < 2; ++a)
#pragma unroll
            for (int b = 0; b < 2; ++b)
#pragma unroll
                for (int m = 0; m < 4; ++m)
#pragma unroll
                    for (int n = 0; n < 2; ++n) acc[a][b][m][n] = (f32x4){0.f, 0.f, 0.f, 0.f};
        }
        cur = nxt; cA = nA; cB = nB; ++ui;
        if (wr == 1) PG8_BAR;
    }
    PG8_WAIT_V(0);
    PG8_BAR;
#undef PG8_SA
#undef PG8_SB
#undef PG8_STAGE
#undef PG8_LDA
#undef PG8_LDB
#undef PG8_MMA
#undef PG8_WAIT_V
#undef PG8_WAIT_L
#undef PG8_BAR
#undef PG8_SCHED
}
}

#define XB_TMO      128
#define XB_XCNT(j)  (256  + 64 * (j))
#define XB_XSUB(j)  (1280 + 64 * (j))
#define XB_XGEN(j)  (2304 + 64 * (j))
#define XB_TOP      3328
#define XB_TOPGEN   3392
#define XCD_BAR_WORDS 3456
#define XB_SPIN_CAP (1u << 18)
__device__ __forceinline__ unsigned xb_ld(unsigned* p)              { return __hip_atomic_load(p, __ATOMIC_RELAXED, __HIP_MEMORY_SCOPE_AGENT); }
__device__ __forceinline__ unsigned xb_add(unsigned* p, unsigned v) { return __hip_atomic_fetch_add(p, v, __ATOMIC_RELAXED, __HIP_MEMORY_SCOPE_AGENT); }
__device__ __forceinline__ unsigned xb_xcc_id() { return (unsigned)__builtin_amdgcn_s_getreg((3 << 11) | 20) & 0xFu; }
#define XB_SPIN(cond, bar) do { unsigned _sp = 0; while (cond) { __builtin_amdgcn_s_sleep(1); \
    if ((++_sp & 255u) == 0u) { if (xb_ld(&(bar)[XB_TMO])) break; if (_sp > XB_SPIN_CAP) { atomicAdd(&(bar)[XB_TMO], 1u); break; } } } } while (0)
struct XcdBarrier { unsigned* bar; unsigned x; volatile LAS unsigned* st; };
__device__ __forceinline__ XcdBarrier xcd_barrier_post(unsigned* bar, volatile LAS unsigned* st) {
    XcdBarrier b; b.bar = bar; b.x = xb_xcc_id(); b.st = st;
    if (threadIdx.x == 0) (void)xb_add(&bar[XB_XCNT(b.x)], 1u);
    return b;
}
__device__ __forceinline__ void xcd_barrier_complete(unsigned* bar, unsigned x, unsigned& nloc, unsigned& nx) {
    const unsigned G = gridDim.x * gridDim.y * gridDim.z;
    unsigned sum, cnt, mine, sp = 0u;
    for (;;) {
        sum = 0u; cnt = 0u; mine = 0u;
#pragma unroll
        for (unsigned j = 0; j < 16; ++j) { const unsigned c = xb_ld(&bar[XB_XCNT(j)]); sum += c; cnt += (c > 0u) ? 1u : 0u; mine = (j == x) ? c : mine; }
        if (sum == G) break;
        __builtin_amdgcn_s_sleep(1);
        if ((++sp & 255u) == 0u) { if (xb_ld(&bar[XB_TMO])) break; if (sp > XB_SPIN_CAP) { atomicAdd(&bar[XB_TMO], 1u); break; } }
    }
    nloc = mine > 0u ? mine : 1u; nx = cnt > 0u ? cnt : 1u;
}
__device__ __forceinline__ void xcd_barrier(const XcdBarrier& b) {
    asm volatile("s_waitcnt vmcnt(0)" ::: "memory");
    __syncthreads();
    if (threadIdx.x == 0) {
        unsigned* bar = b.bar;
        __builtin_amdgcn_s_waitcnt(0);
        unsigned nloc = b.st[0], nx = b.st[1];
        if (nloc == 0u) { xcd_barrier_complete(bar, b.x, nloc, nx); b.st[0] = nloc; b.st[1] = nx; }
        const unsigned old = xb_add(&bar[XB_XSUB(b.x)], 1u);
        const unsigned gen = old / nloc;
        if (old + 1u == (gen + 1u) * nloc) {
            __builtin_amdgcn_fence(__ATOMIC_RELEASE, "agent");
            asm volatile("s_waitcnt vmcnt(0)" ::: "memory");
            const unsigned og = xb_add(&bar[XB_TOP], 1u);
            const unsigned tg = og / nx;
            if (og + 1u == (tg + 1u) * nx) xb_add(&bar[XB_TOPGEN], 1u);
            else XB_SPIN(xb_ld(&bar[XB_TOPGEN]) == tg, bar);
            __builtin_amdgcn_fence(__ATOMIC_ACQUIRE, "agent");
            xb_add(&bar[XB_XGEN(b.x)], 1u);
            asm volatile("s_waitcnt vmcnt(0)" ::: "memory");
        } else {
            XB_SPIN(xb_ld(&bar[XB_XGEN(b.x)]) == gen, bar);
            __builtin_amdgcn_fence(__ATOMIC_ACQUIRE, "agent");
            asm volatile("s_waitcnt vmcnt(0)" ::: "memory");
        }
    }
    __syncthreads();
}

struct Args { const float* in[21]; float* out; unsigned char* ws; int ph_lo, ph_hi; };
struct Frame {
    LAS unsigned char* lds;
    int tid, lane, wave, vcu, G;
    const float* in[21]; float* out; unsigned char* ws;
};
__device__ __forceinline__ float wave_sum(float v) {
#pragma unroll
    for (int o = 1; o < 64; o <<= 1) v += __shfl_xor(v, o);
    return v;
}
__device__ __forceinline__ float wave_max(float v) {
#pragma unroll
    for (int o = 1; o < 64; o <<= 1) v = fmaxf(v, __shfl_xor(v, o));
    return v;
}

__device__ __forceinline__ void p0_transpose_item(const float* W, int ldw, int K, bf16* WT, int k0, int n0, int sc0, const float* kscale, LAS float* scr, int lane) {
#pragma unroll 8
    for (int i = 0; i < 32; ++i) { const int kk = 2 * i + (lane >> 5); float w = W[(size_t)(k0 + kk) * ldw + sc0 + (lane & 31)]; if (kscale) w *= kscale[k0 + kk]; scr[kk * 33 + (lane & 31)] = w; }
    LDS_WAIT(); asm volatile("" ::: "memory");
    const int c = lane & 7;
#pragma unroll
    for (int j = 0; j < 4; ++j) { const int n = (lane >> 3) + 8 * j; const LAS float* s = scr + (8 * c) * 33 + n;
        v4u o; o.x = pk2(s[0 * 33], s[1 * 33]); o.y = pk2(s[2 * 33], s[3 * 33]); o.z = pk2(s[4 * 33], s[5 * 33]); o.w = pk2(s[6 * 33], s[7 * 33]);
        *(GAS v4u*)(WT + (size_t)(n0 + n) * K + k0 + 8 * c) = o; }
    LDS_WAIT(); asm volatile("" ::: "memory");
}
__device__ __forceinline__ void rms_row_to_bf16(int lane, const float* xrow, const float* g, bf16* orow) {
    const GAS f32x4* xr = (const GAS f32x4*)xrow + lane;
    f32x4 v[4]; float s2 = 0.f;
#pragma unroll
    for (int j = 0; j < 4; ++j) { v[j] = xr[64 * j]; s2 += (v[j].x * v[j].x + v[j].y * v[j].y) + (v[j].z * v[j].z + v[j].w * v[j].w); }
    const float rstd = 1.f / sqrtf(wave_sum(s2) * (1.f / DM) + EPS);
    GAS unsigned long long* o8 = (GAS unsigned long long*)orow + lane;
#pragma unroll
    for (int j = 0; j < 4; ++j) { const f32x4 gg = ((const GAS f32x4*)g)[lane + 64 * j];
        o8[64 * j] = (unsigned long long)pk2(v[j].x * rstd * gg.x, v[j].y * rstd * gg.y) | ((unsigned long long)pk2(v[j].z * rstd * gg.z, v[j].w * rstd * gg.w) << 32); }
}
__device__ __forceinline__ void p0_prologue(Frame& F) {
    LAS float* scr = (LAS float*)(F.lds + F.wave * 16384);
    const int gw = F.vcu * NWAVES + F.wave, NGW = F.G * NWAVES;
    constexpr int I_IN = 16 * 176, I_A = 8 * 32, I_O = 16 * 32, I_GU = 16 * 176, I_D = 44 * 32;
    constexpr int NITEMS = I_IN + 2 * I_A + I_O + I_GU + I_D;
    for (int it = gw; it < NITEMS; it += NGW) {
        int r = it;
        if (r < I_IN) { const int kb = r / 176, nb = r % 176; p0_transpose_item(F.in[7], DIN, 1024, (bf16*)(F.ws + WS_WIN), 64 * kb, 32 * nb, 32 * nb, nullptr, scr, F.lane); continue; } r -= I_IN;
        if (r < I_A) { const int kb = r / 32, nb = r % 32; p0_transpose_item(F.in[11], DM, 512, (bf16*)(F.ws + WS_WA), 64 * kb, 32 * nb, 32 * nb, nullptr, scr, F.lane); continue; } r -= I_A;
        if (r < I_A) { const int kb = r / 32, nb = r % 32; p0_transpose_item(F.in[12], DM, 512, (bf16*)(F.ws + WS_WB), 64 * kb, 32 * nb, 32 * nb, nullptr, scr, F.lane); continue; } r -= I_A;
        if (r < I_O) { const int kb = r / 32, nb = r % 32; p0_transpose_item(F.in[13], DM, 1024, (bf16*)(F.ws + WS_WOUT), 64 * kb, 32 * nb, 32 * nb, nullptr, scr, F.lane); continue; } r -= I_O;
        if (r < I_GU) { const int kb = r / 176, nb = r % 176; const int n0 = 32 * nb, pn = n0 >> 8, bj = (n0 >> 7) & 1, jj = n0 & 127;
            p0_transpose_item(bj ? F.in[16] : F.in[15], DFF, 1024, (bf16*)(F.ws + WS_WGU), 64 * kb, n0, 128 * pn + jj, F.in[14], scr, F.lane); continue; } r -= I_GU;
        { const int kb = r / 32, nb = r % 32; p0_transpose_item(F.in[19], DM, DFF, (bf16*)(F.ws + WS_WD), 64 * kb, 32 * nb, 32 * nb, nullptr, scr, F.lane); }
    }
    bf16* H = (bf16*)(F.ws + WS_H);
    for (int m = gw; m < MPAD; m += NGW) {
        if (m < MP) rms_row_to_bf16(F.lane, F.in[0] + (size_t)m * DM, F.in[6], H + (size_t)m * DM);
        else if (m < MV) rms_row_to_bf16(F.lane, F.in[1] + (size_t)(m - MP) * DM, F.in[6], H + (size_t)m * DM);
        else { GAS v4u* o = (GAS v4u*)(H + (size_t)m * DM) + F.lane; o[0] = (v4u){0u, 0u, 0u, 0u}; o[64] = (v4u){0u, 0u, 0u, 0u}; }
    }
}

using pg8::Unit; using pg8::TileOrder;
struct PlainSched {
    TileOrder T; int G, c; const char* A; const char* Bt; size_t tstep;
    __device__ __forceinline__ bool next(int i, Unit& u) const { int pm, pn; if (!T.tile((long)i * G + c, pm, pn)) return false; u.pm = pm; u.pn = pn; u.kind = 0; u.a = A + (size_t)pm * tstep; u.b = Bt + (size_t)pn * tstep; return true; }
};
struct MergeSched {
    TileOrder T; int G, c; const char* A0; const char* A1; const char* B0; const char* B1; size_t tstep;
    __device__ __forceinline__ bool next(int i, Unit& u) const { int pm, pn; if (!T.tile((long)(i >> 1) * G + c, pm, pn)) return false; u.pm = pm; u.pn = pn; u.kind = i & 1;
        u.a = ((i & 1) ? A1 : A0) + (size_t)pm * tstep; u.b = ((i & 1) ? B1 : B0) + (size_t)pn * tstep; return true; }
};

#define EPI_ROW(u, ai, m) ((u).pm * 256 + (ai) * 128 + wr * 64 + (m) * 16 + fr)
#define EPI_COLT(bj) ((bj) * 128 + wc * 32 + fq * 8)

struct EpiIn {
    unsigned char* ws; const float* lbl; float* out;
    __device__ __forceinline__ bool keep(const Unit&) const { return false; }
    __device__ __forceinline__ void operator()(f32x4 (&acc)[2][2][4][2], const Unit& u, int wr, int wc, int fr, int fq) const {
        const int pn = u.pn;
        int seg, pn0;
        if (pn < 2) { seg = 0; pn0 = 0; } else if (pn < 4) { seg = 1; pn0 = 2; } else if (pn < 6) { seg = 2; pn0 = 4; } else if (pn < 8) { seg = 3; pn0 = 6; } else if (pn < 10) { seg = 4; pn0 = 8; }
        else if (pn < 12) { seg = 5; pn0 = 10; } else if (pn < 14) { seg = 6; pn0 = 12; } else if (pn < 18) { seg = 7; pn0 = 14; } else { seg = 8; pn0 = 18; }
        const int cseg0 = (pn - pn0) * 256;
        if (seg == 4) {
            float* LF = (float*)(ws + WS_LF);
#pragma unroll
            for (int bj = 0; bj < 2; ++bj) { const int cs = cseg0 + EPI_COLT(bj);
                float lb[8];
#pragma unroll
                for (int j = 0; j < 8; ++j) lb[j] = __builtin_amdgcn_rcpf(1.0f + fast_exp(lbl[512 + cs + j] - lbl[cs + j]));
#pragma unroll
                for (int ai = 0; ai < 2; ++ai)
#pragma unroll
                    for (int m = 0; m < 4; ++m) { const int row = EPI_ROW(u, ai, m); f32x4 o0, o1;
#pragma unroll
                        for (int j = 0; j < 4; ++j) { const float f0 = lb[j] + (1.0f - lb[j]) * fast_sigmoid(acc[ai][bj][m][0][j]); o0[j] = __builtin_amdgcn_logf(f0) * LN2;
                                                       const float f1 = lb[4 + j] + (1.0f - lb[4 + j]) * fast_sigmoid(acc[ai][bj][m][1][j]); o1[j] = __builtin_amdgcn_logf(f1) * LN2; }
                        float* p = LF + (size_t)row * 512 + cs; *(f32x4*)p = o0; *(f32x4*)(p + 4) = o1; } }
            return;
        }
        bf16* dst; int ld, act;
        switch (seg) {
            case 0: dst = (bf16*)(ws + WS_QA); ld = 512; act = 1; break;
            case 1: dst = (bf16*)(ws + WS_KA); ld = 512; act = 0; break;
            case 2: dst = (bf16*)(ws + WS_VA); ld = 512; act = 0; break;
            case 3: dst = (bf16*)(ws + WS_QB); ld = 512; act = 2; break;
            case 5: dst = (bf16*)(ws + WS_VB); ld = 512; act = 0; break;
            case 6: dst = (bf16*)(ws + WS_GB); ld = 512; act = 2; break;
            case 7: dst = (bf16*)(ws + WS_ZA); ld = 1024; act = 3; break;
            default: dst = (bf16*)(ws + WS_ZB); ld = 1024; act = 3; break;
        }
        const bool kvout = (seg == 1 || seg == 2) && (u.pm == 128 || (u.pm & 63) >= 62);
#pragma unroll
        for (int ai = 0; ai < 2; ++ai)
#pragma unroll
            for (int m = 0; m < 4; ++m) { const int row = EPI_ROW(u, ai, m);
#pragma unroll
                for (int bj = 0; bj < 2; ++bj) { const int cs = cseg0 + EPI_COLT(bj);
                    f32x4 v0 = acc[ai][bj][m][0], v1 = acc[ai][bj][m][1];
                    if (act == 1) { v0 = v0 * QSCALE; v1 = v1 * QSCALE; }
                    else if (act >= 2) {
#pragma unroll
                        for (int j = 0; j < 4; ++j) { const float s0 = fast_sigmoid(v0[j]), s1 = fast_sigmoid(v1[j]); v0[j] = (act == 2) ? v0[j] * s0 : s0; v1[j] = (act == 2) ? v1[j] * s1 : s1; } }
                    v4u w; w.x = pk2(v0[0], v0[1]); w.y = pk2(v0[2], v0[3]); w.z = pk2(v1[0], v1[1]); w.w = pk2(v1[2], v1[3]);
                    *(v4u*)(dst + (size_t)row * ld + cs) = w;
                    if (kvout) {
                        const int hh = cs >> 6, d = cs & 63; float* o = nullptr;
                        if (row < MP) { const int b = row >> 14, t = row & 16383; if (t >= SEQ - 512) o = out + (seg == 1 ? O_KP : O_VP) + ((size_t)(b * 8 + hh) * 512 + (t - (SEQ - 512))) * 64 + d; }
                        else if (row < MV) { const int bs = (row - MP) >> 4, ts = (row - MP) & 15; o = out + (seg == 1 ? O_KS : O_VS) + ((size_t)(bs * 8 + hh) * 16 + ts) * 64 + d; }
                        if (o) { *(f32x4*)o = v0; *(f32x4*)(o + 4) = v1; }
                    } } }
    }
};

struct EpiMerge {
    const bf16* ZA; const bf16* ZB; bf16* MG;
    __device__ __forceinline__ bool keep(const Unit& u) const { return u.kind == 0; }
    __device__ __forceinline__ void operator()(f32x4 (&acc)[2][2][4][2], const Unit& u, int wr, int wc, int fr, int fq) const {
#pragma unroll
        for (int ai = 0; ai < 2; ++ai)
#pragma unroll
            for (int m = 0; m < 4; ++m) { const int row = EPI_ROW(u, ai, m);
#pragma unroll
                for (int bj = 0; bj < 2; ++bj) { const size_t off = (size_t)row * 1024 + u.pn * 256 + EPI_COLT(bj);
                    const v4u zb = *(const v4u*)(ZB + off);
                    float gb[8] = {bflo(zb.x), bfhi(zb.x), bflo(zb.y), bfhi(zb.y), bflo(zb.z), bfhi(zb.z), bflo(zb.w), bfhi(zb.w)};
                    if (u.kind == 0) {
                        const v4u za = *(const v4u*)(ZA + off);
                        float ga[8] = {bflo(za.x), bfhi(za.x), bflo(za.y), bfhi(za.y), bflo(za.z), bfhi(za.z), bflo(za.w), bfhi(za.w)};
#pragma unroll
                        for (int j = 0; j < 4; ++j) { acc[ai][bj][m][0][j] *= ga[j] * __builtin_amdgcn_rcpf(gb[j]); acc[ai][bj][m][1][j] *= ga[4 + j] * __builtin_amdgcn_rcpf(gb[4 + j]); }
                    } else {
                        f32x4 v0 = acc[ai][bj][m][0], v1 = acc[ai][bj][m][1];
#pragma unroll
                        for (int j = 0; j < 4; ++j) { v0[j] *= gb[j]; v1[j] *= gb[4 + j]; }
                        v4u w; w.x = pk2(v0[0], v0[1]); w.y = pk2(v0[2], v0[3]); w.z = pk2(v1[0], v1[1]); w.w = pk2(v1[2], v1[3]);
                        *(v4u*)(MG + off) = w;
                    } } }
    }
};

template <bool DOWN> struct EpiRes {
    const float* xp; const float* xs; float* out; bf16* X1B; float* RS;
    __device__ __forceinline__ bool keep(const Unit&) const { return false; }
    __device__ __forceinline__ void operator()(f32x4 (&acc)[2][2][4][2], const Unit& u, int wr, int wc, int fr, int fq) const {
#pragma unroll
        for (int ai = 0; ai < 2; ++ai)
#pragma unroll
            for (int m = 0; m < 4; ++m) { const int row = EPI_ROW(u, ai, m); float ss = 0.f;
                const bool valid = row < MV;
#pragma unroll
                for (int bj = 0; bj < 2; ++bj) { const int col = u.pn * 256 + EPI_COLT(bj);
                    f32x4 v0 = acc[ai][bj][m][0], v1 = acc[ai][bj][m][1];
                    if (valid) {
                        const float* src = DOWN ? out + (size_t)row * DM + col : (row < MP ? xp + (size_t)row * DM + col : xs + (size_t)(row - MP) * DM + col);
                        v0 = v0 + *(const f32x4*)src; v1 = v1 + *(const f32x4*)(src + 4);
                        float* o = out + (size_t)row * DM + col; *(f32x4*)o = v0; *(f32x4*)(o + 4) = v1;
                    }
                    if (!DOWN) { v4u w; w.x = pk2(v0[0], v0[1]); w.y = pk2(v0[2], v0[3]); w.z = pk2(v1[0], v1[1]); w.w = pk2(v1[2], v1[3]); *(v4u*)(X1B + (size_t)row * DM + col) = w; }
                    ss += (v0[0] * v0[0] + v0[1] * v0[1]) + (v0[2] * v0[2] + v0[3] * v0[3]) + (v1[0] * v1[0] + v1[1] * v1[1]) + (v1[2] * v1[2] + v1[3] * v1[3]); }
                ss += __shfl_xor(ss, 16); ss += __shfl_xor(ss, 32);
                if (fq == 0) RS[(size_t)row * 16 + u.pn * 4 + wc] = ss; }
    }
};
__device__ __forceinline__ float row_rstd(const float* RS, int row) {
    const f32x4* p = (const f32x4*)(RS + (size_t)row * 16);
    const f32x4 a = p[0], b = p[1], c = p[2], d = p[3];
    const float s = ((a[0] + a[1]) + (a[2] + a[3])) + ((b[0] + b[1]) + (b[2] + b[3])) + ((c[0] + c[1]) + (c[2] + c[3])) + ((d[0] + d[1]) + (d[2] + d[3]));
    return 1.0f / sqrtf(s * (1.0f / DM) + EPS);
}

struct EpiGU {
    const float* RS; bf16* AB; bf16* UB;
    __device__ __forceinline__ bool keep(const Unit&) const { return false; }
    __device__ __forceinline__ void operator()(f32x4 (&acc)[2][2][4][2], const Unit& u, int wr, int wc, int fr, int fq) const {
#pragma unroll
        for (int ai = 0; ai < 2; ++ai)
#pragma unroll
            for (int m = 0; m < 4; ++m) { const int row = EPI_ROW(u, ai, m); const float rs = row_rstd(RS, row);
#pragma unroll
                for (int bj = 0; bj < 2; ++bj) { const size_t off = (size_t)row * DFF + u.pn * 128 + wc * 32 + fq * 8;
                    const f32x4 v0 = acc[ai][bj][m][0] * rs, v1 = acc[ai][bj][m][1] * rs;
                    v4u w; w.x = pk2(v0[0], v0[1]); w.y = pk2(v0[2], v0[3]); w.z = pk2(v1[0], v1[1]); w.w = pk2(v1[2], v1[3]);
                    *(v4u*)((bj ? UB : AB) + off) = w; } }
    }
};

__device__ __forceinline__ float dot8(const v4u q, const v4u k) {
    return (bflo(q.x) * bflo(k.x) + bfhi(q.x) * bfhi(k.x)) + (bflo(q.y) * bflo(k.y) + bfhi(q.y) * bfhi(k.y)) + (bflo(q.z) * bflo(k.z) + bfhi(q.z) * bfhi(k.z)) + (bflo(q.w) * bflo(k.w) + bfhi(q.w) * bfhi(k.w));
}
__device__ __forceinline__ float dot8f(const v4u q, const f32x4 k0, const f32x4 k1) {
    return (bflo(q.x) * k0[0] + bfhi(q.x) * k0[1]) + (bflo(q.y) * k0[2] + bfhi(q.y) * k0[3]) + (bflo(q.z) * k1[0] + bfhi(q.z) * k1[1]) + (bflo(q.w) * k1[2] + bfhi(q.w) * k1[3]);
}
template <bool SAMPLE>
__device__ __forceinline__ void attn_simple_row(Frame& F, int qrow, int h) {
    const bf16* QA = (const bf16*)(F.ws + WS_QA); const bf16* KA = (const bf16*)(F.ws + WS_KA); const bf16* VA = (const bf16*)(F.ws + WS_VA);
    bf16* OA = (bf16*)(F.ws + WS_QA);
    const float* bias = F.in[8] + h * NREL;
    const int lane = F.lane;
    v4u q8[8];
#pragma unroll
    for (int i = 0; i < 8; ++i) q8[i] = *(const v4u*)(QA + (size_t)qrow * 512 + 64 * h + 8 * i);
    int b, qpos, kbase, nk;
    if (!SAMPLE) { b = qrow >> 14; qpos = qrow & 16383; kbase = 64 * ((qpos >> 6) - 8); nk = 576; }
    else { b = (qrow - MP) >> 4; qpos = PAST + ((qrow - MP) & 15); kbase = PAST - 512; nk = 528; }
    LAS float* wsc = (LAS float*)(F.lds + 32768 + F.wave * 4096);
    float mx = -INFINITY;
#pragma unroll 1
    for (int r = 0; r < 9; ++r) {
        const int j = 64 * r + lane; float sc = -INFINITY;
        if (j < nk) {
            const int kpos = kbase + j;
            if (!SAMPLE) {
                if (kpos >= 0) { const bf16* kp = KA + ((size_t)b * SEQ + kpos) * 512 + 64 * h; float d = 0.f;
#pragma unroll
                    for (int i = 0; i < 8; ++i) d += dot8(q8[i], *(const v4u*)(kp + 8 * i));
                    int dd = qpos - kpos; dd = dd < -63 ? -63 : (dd > 128 ? 128 : dd); sc = d + bias[dd + 63] * LOG2E; }
            } else {
                float d = 0.f;
                if (j < 512) { const float* kp = F.in[2] + ((size_t)(b * 8 + h) * 512 + j) * 64;
#pragma unroll
                    for (int i = 0; i < 8; ++i) d += dot8f(q8[i], *(const f32x4*)(kp + 8 * i), *(const f32x4*)(kp + 8 * i + 4)); }
                else { const bf16* kp = KA + ((size_t)MP + b * 16 + (j - 512)) * 512 + 64 * h;
#pragma unroll
                    for (int i = 0; i < 8; ++i) d += dot8(q8[i], *(const v4u*)(kp + 8 * i)); }
                int dd = qpos - kpos; dd = dd < -63 ? -63 : (dd > 128 ? 128 : dd); sc = d + bias[dd + 63] * LOG2E;
            }
        }
        wsc[j] = sc; mx = fmaxf(mx, sc);
    }
    mx = wave_max(mx); float l = 0.f;
#pragma unroll 1
    for (int r = 0; r < 9; ++r) { const float p = __builtin_amdgcn_exp2f(wsc[64 * r + lane] - mx); wsc[64 * r + lane] = p; l += p; }
    l = wave_sum(l);
    LDS_WAIT();
    float o = 0.f;
    const int jlo = (!SAMPLE && kbase < 0) ? -kbase : 0;
#pragma unroll 4
    for (int j = jlo; j < nk; ++j) {
        const float p = wsc[j];
        float vv;
        if (!SAMPLE) vv = bf2f(VA[((size_t)b * SEQ + kbase + j) * 512 + 64 * h + lane]);
        else if (j < 512) vv = F.in[3][((size_t)(b * 8 + h) * 512 + j) * 64 + lane];
        else vv = bf2f(VA[((size_t)MP + b * 16 + (j - 512)) * 512 + 64 * h + lane]);
        o += p * vv;
    }
    o *= __builtin_amdgcn_rcpf(l);
    const unsigned ob = pk2(o, 0.f) & 0xffffu;
    OA[(size_t)qrow * 512 + 64 * h + lane] = (bf16)ob;
}

__device__ __forceinline__ void hgrn_simple(Frame& F, int row0, int L, int h, const float* S0, float* Sout) {
    const float* LF = (const float*)(F.ws + WS_LF); const bf16* QB = (const bf16*)(F.ws + WS_QB); const bf16* VB = (const bf16*)(F.ws + WS_VB); const bf16* GB = (const bf16*)(F.ws + WS_GB);
    bf16* OB = (bf16*)(F.ws + WS_QB);
    const float* gn = F.in[10];
    const int tid = F.tid, v = tid & 127, kg = __builtin_amdgcn_readfirstlane(tid >> 7);
    LAS float* opart = (LAS float*)F.lds;
    float S[32];
#pragma unroll
    for (int i = 0; i < 32; ++i) S[i] = S0 ? S0[(size_t)(32 * kg + i) * 128 + v] : 0.f;
    for (int t0 = 0; t0 < L; t0 += 16) {
        for (int tt = 0; tt < 16; ++tt) {
            const size_t row = (size_t)row0 + t0 + tt;
            const float* lf = LF + row * 512 + 128 * h + 32 * kg;
            const bf16* qp = QB + row * 512 + 128 * h + 32 * kg;
            const float vv = bf2f(VB[row * 512 + 128 * h + v]);
            float acc = 0.f;
#pragma unroll
            for (int i = 0; i < 32; ++i) { const float f = fast_exp(lf[i]); S[i] = f * S[i] + (1.0f - f) * vv; acc += bf2f(qp[i]) * S[i]; }
            opart[(tt * 4 + kg) * 128 + v] = acc;
        }
        __syncthreads();
        {
            const int tt = tid >> 5, v4 = (tid & 31) * 4; const size_t row = (size_t)row0 + t0 + tt;
            float o[4]; float ss = 0.f;
#pragma unroll
            for (int i = 0; i < 4; ++i) { o[i] = (opart[(tt * 4 + 0) * 128 + v4 + i] + opart[(tt * 4 + 1) * 128 + v4 + i]) + (opart[(tt * 4 + 2) * 128 + v4 + i] + opart[(tt * 4 + 3) * 128 + v4 + i]); ss += o[i] * o[i]; }
#pragma unroll
            for (int of = 1; of < 32; of <<= 1) ss += __shfl_xor(ss, of);
            const float rstd = 1.0f / sqrtf(ss * (1.0f / 128.0f) + EPS);
            const bf16* gp = GB + row * 512 + 128 * h + v4;
            float r[4];
#pragma unroll
            for (int i = 0; i < 4; ++i) r[i] = o[i] * rstd * gn[v4 + i] * bf2f(gp[i]);
            unsigned long long w = (unsigned long long)pk2(r[0], r[1]) | ((unsigned long long)pk2(r[2], r[3]) << 32);
            *(unsigned long long*)(OB + row * 512 + 128 * h + v4) = w;
        }
        __syncthreads();
    }
#pragma unroll
    for (int i = 0; i < 32; ++i) Sout[(size_t)(32 * kg + i) * 128 + v] = S[i];
}

__device__ __forceinline__ float gelu_tanh(float x) { const float z = 1.5957691216057308f * (x + 0.044715f * x * x * x); return x * __builtin_amdgcn_rcpf(1.0f + __builtin_amdgcn_exp2f(-z * LOG2E)); }
__device__ __forceinline__ void conv_phase(Frame& F) {
    const bf16* AB = (const bf16*)(F.ws + WS_AB); bf16* UB = (bf16*)(F.ws + WS_UB);
    const float* cw = F.in[17]; const float* cb = F.in[18]; const float* st = F.in[5];
    const int gt = F.vcu * 512 + F.tid, NT = F.G * 512;
    constexpr int CPR = DFF / 8;
    for (long it = gt; it < (long)MV * CPR; it += NT) {
        const int row = (int)(it / CPR), c8 = (int)(it % CPR) * 8;
        int t, L; if (row < MP) { t = row & 16383; L = 0; } else { t = (row - MP) & 15; L = 1; }
        float a0[8], a1[8], a2[8];
        { const v4u w = *(const v4u*)(AB + (size_t)row * DFF + c8); a2[0] = bflo(w.x); a2[1] = bfhi(w.x); a2[2] = bflo(w.y); a2[3] = bfhi(w.y); a2[4] = bflo(w.z); a2[5] = bfhi(w.z); a2[6] = bflo(w.w); a2[7] = bfhi(w.w); }
        if (t >= 1) { const v4u w = *(const v4u*)(AB + (size_t)(row - 1) * DFF + c8); a1[0] = bflo(w.x); a1[1] = bfhi(w.x); a1[2] = bflo(w.y); a1[3] = bfhi(w.y); a1[4] = bflo(w.z); a1[5] = bfhi(w.z); a1[6] = bflo(w.w); a1[7] = bfhi(w.w); }
        else { if (L) { const float* p = st + ((size_t)((row - MP) >> 4) * 2 + 1) * DFF + c8;
#pragma unroll
                for (int j = 0; j < 8; ++j) a1[j] = p[j]; } else {
#pragma unroll
                for (int j = 0; j < 8; ++j) a1[j] = 0.f; } }
        if (t >= 2) { const v4u w = *(const v4u*)(AB + (size_t)(row - 2) * DFF + c8); a0[0] = bflo(w.x); a0[1] = bfhi(w.x); a0[2] = bflo(w.y); a0[3] = bfhi(w.y); a0[4] = bflo(w.z); a0[5] = bfhi(w.z); a0[6] = bflo(w.w); a0[7] = bfhi(w.w); }
        else { if (L) { const float* p = st + ((size_t)((row - MP) >> 4) * 2 + t) * DFF + c8;
#pragma unroll
                for (int j = 0; j < 8; ++j) a0[j] = p[j]; } else {
#pragma unroll
                for (int j = 0; j < 8; ++j) a0[j] = 0.f; } }
        const v4u uw = *(const v4u*)(UB + (size_t)row * DFF + c8);
        float uu[8] = {bflo(uw.x), bfhi(uw.x), bflo(uw.y), bfhi(uw.y), bflo(uw.z), bfhi(uw.z), bflo(uw.w), bfhi(uw.w)};
        float g[8];
#pragma unroll
        for (int j = 0; j < 8; ++j) { const float ac = cb[c8 + j] + cw[c8 + j] * a0[j] + cw[DFF + c8 + j] * a1[j] + cw[2 * DFF + c8 + j] * a2[j]; g[j] = gelu_tanh(ac) * uu[j]; }
        v4u w; w.x = pk2(g[0], g[1]); w.y = pk2(g[2], g[3]); w.z = pk2(g[4], g[5]); w.w = pk2(g[6], g[7]);
        *(v4u*)(UB + (size_t)row * DFF + c8) = w;
        if (!L && t >= SEQ - 2) { float* o = F.out + O_CP + ((size_t)(row >> 14) * 2 + (t - (SEQ - 2))) * DFF + c8;
#pragma unroll
            for (int j = 0; j < 8; ++j) o[j] = a2[j]; }
        if (L && t >= DSEQ - 2) { float* o = F.out + O_CS + ((size_t)((row - MP) >> 4) * 2 + (t - (DSEQ - 2))) * DFF + c8;
#pragma unroll
            for (int j = 0; j < 8; ++j) o[j] = a2[j]; }
    }
}
__device__ __forceinline__ void final_norm_phase(Frame& F) {
    const float* RS = (const float*)(F.ws + WS_RS2); const float* g = F.in[20];
    const int gw = F.vcu * NWAVES + F.wave, NGW = F.G * NWAVES;
    for (int m = gw; m < MV; m += NGW) {
        const float rs = row_rstd(RS, m);
        GAS f32x4* xr = (GAS f32x4*)(F.out + (size_t)m * DM) + F.lane;
#pragma unroll
        for (int j = 0; j < 4; ++j) { const f32x4 gg = ((const GAS f32x4*)g)[F.lane + 64 * j]; f32x4 v = xr[64 * j]; v = v * rs * gg; xr[64 * j] = v; }
    }
}

constexpr int N_PHASES = 11;
__global__ void __launch_bounds__(NWAVES * 64, 2) mk_fwd(Args args) {
    extern __shared__ __attribute__((aligned(16))) unsigned char lds[];
    Frame F;
    F.lds = (LAS unsigned char*)lds;
    F.tid = threadIdx.x; F.lane = F.tid & 63; F.wave = __builtin_amdgcn_readfirstlane(F.tid >> 6);
    F.G = gridDim.x; { const int bx = blockIdx.x; F.vcu = (F.G % 8 == 0) ? (bx % 8) * (F.G / 8) + bx / 8 : bx; }
#pragma unroll
    for (int i = 0; i < 21; ++i) F.in[i] = args.in[i];
    F.out = args.out; F.ws = args.ws;
    for (int u = F.tid; u < (LDS_BYTES - LDSCTL_OFF) / 4; u += NWAVES * 64) ((LAS unsigned*)(F.lds + LDSCTL_OFF))[u] = 0u;
    __syncthreads();
    gu32* ctl = (gu32*)(F.ws + WS_CTL);
    XcdBarrier bar; bar.bar = (unsigned*)(ctl + CW_BAR); bar.x = 0; bar.st = nullptr;
    if (MK_N_LAUNCHES == 1) bar = xcd_barrier_post((unsigned*)(ctl + CW_BAR), (volatile LAS unsigned*)(F.lds + MISC_OFF) + 8);
    const int lo = args.ph_lo, hi = args.ph_hi;
#ifndef PHMASK
#define PHMASK 0xffff
#endif
#define IN(k) (((PHMASK >> (k)) & 1) && lo <= (k) && (k) < hi)
#define SEAM(k) do { if (IN(k) && IN((k) + 1)) xcd_barrier(bar); } while (0)

    if (IN(0)) { p0_prologue(F); }
    SEAM(0);
    if (IN(1)) {
        PlainSched S; S.T.init(MPAD / 256, DIN / 256); S.G = F.G; S.c = (int)blockIdx.x; S.A = (const char*)(F.ws + WS_H); S.Bt = (const char*)(F.ws + WS_WIN); S.tstep = (size_t)256 * 1024 * 2;
        EpiIn E{F.ws, F.in[9], F.out};
        pg8::gemm_phase(F.lds, 1024, S, E);
    }
    SEAM(1);
    if (IN(2)) {
        const int gw = F.vcu * NWAVES + F.wave, NGW = F.G * NWAVES;
        if (blockIdx.x < 8) { const int b = blockIdx.x >> 2, h = blockIdx.x & 3; hgrn_simple(F, b * SEQ, SEQ, h, nullptr, F.out + O_HP + (size_t)(b * 4 + h) * 16384); }
        else if (blockIdx.x < 40) { const int i = blockIdx.x - 8, b = i >> 2, h = i & 3; hgrn_simple(F, MP + b * DSEQ, DSEQ, h, F.in[4] + (size_t)(b * 4 + h) * 16384, F.out + O_HS + (size_t)(b * 4 + h) * 16384); }
        else {
            const int w0 = (blockIdx.x - 40) * NWAVES + F.wave, NW2 = (F.G - 40) * NWAVES;
            for (int it = w0; it < MV * NHA; it += NW2) { const int qrow = it >> 3, h = it & 7; if (qrow < MP) attn_simple_row<false>(F, qrow, h); else attn_simple_row<true>(F, qrow, h); }
        }
        (void)gw; (void)NGW;
    }
    SEAM(2);
    if (IN(5)) {
        MergeSched S; S.T.init(MPAD / 256, DM / 256); S.G = F.G; S.c = (int)blockIdx.x; S.A0 = (const char*)(F.ws + WS_QA); S.A1 = (const char*)(F.ws + WS_QB);
        S.B0 = (const char*)(F.ws + WS_WA); S.B1 = (const char*)(F.ws + WS_WB); S.tstep = (size_t)256 * 512 * 2;
        EpiMerge E{(const bf16*)(F.ws + WS_ZA), (const bf16*)(F.ws + WS_ZB), (bf16*)(F.ws + WS_MG)};
        pg8::gemm_phase(F.lds, 512, S, E);
    }
    SEAM(5);
    if (IN(6)) {
        PlainSched S; S.T.init(MPAD / 256, DM / 256); S.G = F.G; S.c = (int)blockIdx.x; S.A = (const char*)(F.ws + WS_MG); S.Bt = (const char*)(F.ws + WS_WOUT); S.tstep = (size_t)256 * 1024 * 2;
        EpiRes<false> E{F.in[0], F.in[1], F.out, (bf16*)(F.ws + WS_X1B), (float*)(F.ws + WS_RS1)};
        pg8::gemm_phase(F.lds, 1024, S, E);
    }
    SEAM(6);
    if (IN(7)) {
        PlainSched S; S.T.init(MPAD / 256, DIN / 256); S.G = F.G; S.c = (int)blockIdx.x; S.A = (const char*)(F.ws + WS_X1B); S.Bt = (const char*)(F.ws + WS_WGU); S.tstep = (size_t)256 * 1024 * 2;
        EpiGU E{(const float*)(F.ws + WS_RS1), (bf16*)(F.ws + WS_AB), (bf16*)(F.ws + WS_UB)};
        pg8::gemm_phase(F.lds, 1024, S, E);
    }
    SEAM(7);
    if (IN(8)) { conv_phase(F); }
    SEAM(8);
    if (IN(9)) {
        PlainSched S; S.T.init(MPAD / 256, DM / 256); S.G = F.G; S.c = (int)blockIdx.x; S.A = (const char*)(F.ws + WS_UB); S.Bt = (const char*)(F.ws + WS_WD); S.tstep = (size_t)256 * DFF * 2;
        EpiRes<true> E{nullptr, nullptr, F.out, nullptr, (float*)(F.ws + WS_RS2)};
        pg8::gemm_phase(F.lds, DFF, S, E);
    }
    SEAM(9);
    if (IN(10)) { final_norm_phase(F); }
#undef IN
#undef SEAM
}

extern "C" void kernel_launch(void* const* d_in, const int* in_sizes, int n_in, void* d_out, int out_size, void* d_ws, size_t ws_size, hipStream_t stream) {
    static int grid = 0;
    if (grid == 0) {
        if (n_in != 21 || out_size != (int)O_END || ws_size < WS_END) { fprintf(stderr, "kernel_launch: unexpected shapes: n_in %d out %d ws %zu (need %zu)\n", n_in, out_size, ws_size, (size_t)WS_END); grid = -1; return; }
        int dev = 0, cus = 0, per_cu = 0;
        if (hipGetDevice(&dev) != hipSuccess || hipDeviceGetAttribute(&cus, hipDeviceAttributeMultiprocessorCount, dev) != hipSuccess) { grid = -1; return; }
        if (hipFuncSetAttribute((const void*)mk_fwd, hipFuncAttributeMaxDynamicSharedMemorySize, LDS_BYTES) != hipSuccess) { fprintf(stderr, "kernel_launch: hipFuncSetAttribute failed\n"); grid = -1; return; }
        if (hipOccupancyMaxActiveBlocksPerMultiprocessor(&per_cu, (const void*)mk_fwd, NWAVES * 64, LDS_BYTES) != hipSuccess || per_cu < 1) fprintf(stderr, "kernel_launch: occupancy query says %d\n", per_cu);
        (void)hipGetLastError();
        grid = cus;
    }
    if (grid < 0) return;
    (void)hipMemsetAsync((char*)d_ws + WS_CTL, 0, CTL_ZERO_BYTES, stream);
    Args a{};
    for (int i = 0; i < 21; ++i) a.in[i] = (const float*)d_in[i];
    a.out = (float*)d_out; a.ws = (unsigned char*)d_ws;
    if (MK_N_LAUNCHES == 1) { a.ph_lo = 0; a.ph_hi = N_PHASES; hipLaunchKernelGGL(mk_fwd, dim3(grid), dim3(NWAVES * 64), LDS_BYTES, stream, a); }
    else { for (int p = 0; p < N_PHASES; ++p) { a.ph_lo = p; a.ph_hi = p + 1; hipLaunchKernelGGL(mk_fwd, dim3(grid), dim3(NWAVES * 64), LDS_BYTES, stream, a); } }
}
```

```cpp
#include <hip/hip_runtime.h>
#include <cstdio>
#include <cstdint>

#ifndef MK_N_LAUNCHES
#define MK_N_LAUNCHES 1
#endif

constexpr int DM = 1024, NBATCH = 2, SEQ = 16384, DBATCH = 8, DSEQ = 16, PAST = 4096;
constexpr int MP = NBATCH * SEQ;
constexpr int MS = DBATCH * DSEQ;
constexpr int MV = MP + MS;
constexpr int MPAD = 33024;
constexpr int DIN = 5632, DFF = 2816, DA = 512;
constexpr int NHA = 8, NHB = 4;
constexpr int NREL = 192;
constexpr float EPS = 1e-6f;
constexpr float LOG2E = 1.4426950408889634f;
constexpr float LN2 = 0.6931471805599453f;
constexpr float QSCALE = 0.125f * LOG2E;

constexpr size_t O_Y = 0, O_KP = 33685504, O_VP = 34209792, O_HP = 34734080, O_CP = 34865152, O_KS = 34876416, O_VS = 34941952, O_HS = 35007488, O_CS = 35531776, O_END = 35576832;

constexpr size_t MiB = 1u << 20;
constexpr size_t WS_CTL = 0, CTL_ZERO_BYTES = 1 * MiB;
constexpr size_t WS_WIN = 2 * MiB, WS_WA = 13 * MiB, WS_WB = 14 * MiB, WS_WOUT = 15 * MiB, WS_WGU = 17 * MiB, WS_WD = 28 * MiB;
constexpr size_t WS_RS1 = 34 * MiB, WS_RS2 = 37 * MiB;
constexpr size_t SZ_R512 = (size_t)MPAD * 512 * 2, SZ_R1024 = (size_t)MPAD * 1024 * 2;
constexpr size_t WS_H = 40 * MiB;
constexpr size_t WS_QA = 105 * MiB, WS_KA = WS_QA + SZ_R512, WS_VA = WS_KA + SZ_R512, WS_QB = WS_VA + SZ_R512, WS_VB = WS_QB + SZ_R512, WS_GB = WS_VB + SZ_R512;
constexpr size_t WS_LF = WS_GB + SZ_R512;
constexpr size_t WS_ZA = WS_LF + SZ_R1024, WS_ZB = WS_ZA + SZ_R1024;
constexpr size_t WS_DC = WS_ZB + SZ_R1024;
constexpr size_t WS_END = WS_DC + 1 * MiB;
constexpr size_t WS_MG = WS_KA;
constexpr size_t WS_X1B = WS_H;
constexpr size_t WS_US = WS_H;
constexpr size_t SZ_FF = (size_t)MPAD * DFF * 2;
constexpr size_t WS_AB = WS_QA, WS_UB = WS_AB + SZ_FF;
static_assert(WS_UB + SZ_FF <= WS_DC && WS_END <= 512 * MiB, "d_ws map");

constexpr int CW_TMO = 0, CW_BAR = 4096;

constexpr int RING_BYTES = 131072, LDS_BYTES = 163840, LDSCTL_OFF = LDS_BYTES - 512, MISC_OFF = LDSCTL_OFF + 320;
constexpr int NWAVES = 8;

#define GAS __attribute__((address_space(1)))
#define LAS __attribute__((address_space(3)))
typedef unsigned short bf16;
typedef unsigned v4u __attribute__((ext_vector_type(4)));
typedef float f32x4 __attribute__((ext_vector_type(4)));
typedef float f32x2 __attribute__((ext_vector_type(2)));
typedef __bf16 bf16x2_t __attribute__((ext_vector_type(2)));
typedef short bf16x8 __attribute__((ext_vector_type(8)));
typedef GAS unsigned gu32;
#define RLX_AGENT __ATOMIC_RELAXED, __HIP_MEMORY_SCOPE_AGENT
#define LDS_WAIT() asm volatile("s_waitcnt lgkmcnt(0)" ::: "memory")
#define VM_WAIT() asm volatile("s_waitcnt vmcnt(0)" ::: "memory")

__device__ __forceinline__ unsigned pk2(float lo, float hi) { f32x2 v = {lo, hi}; bf16x2_t b = __builtin_convertvector(v, bf16x2_t); return __builtin_bit_cast(unsigned, b); }
typedef float f32x16 __attribute__((ext_vector_type(16)));
__device__ __forceinline__ int crow(int r, int hi) { return (r & 3) + 8 * (r >> 2) + 4 * hi; }
__device__ __forceinline__ unsigned short bf1(float x) { return (unsigned short)(pk2(x, x) & 0xffffu); }
__device__ __forceinline__ float bf2f(unsigned short x) { return __uint_as_float((unsigned)x << 16); }
__device__ __forceinline__ float bflo(unsigned w) { return __uint_as_float(w << 16); }
__device__ __forceinline__ float bfhi(unsigned w) { return __uint_as_float(w & 0xffff0000u); }
__device__ __forceinline__ float fast_sigmoid(float x) { return __builtin_amdgcn_rcpf(1.0f + __builtin_amdgcn_exp2f(-x * LOG2E)); }
__device__ __forceinline__ float fast_exp(float x) { return __builtin_amdgcn_exp2f(x * LOG2E); }

namespace pg8 {
#define PG8_LAS __attribute__((address_space(3)))
typedef unsigned short bf16_t;
constexpr int BM = 256, BK = 64, HALF = 128, HTB = HALF * BK * 2, STAGE_BYTES = 8 * HTB, NXCD = 8, WGM = 8;
__host__ __device__ __forceinline__ int lds_byte(int r, int c) { const int st = (r >> 4) * 2 + (c >> 5), rr = r & 15, cc = c & 31, ob = rr * 64 + cc * 2; return st * 1024 + (ob ^ (((ob >> 9) & 1) << 5)); }
__host__ __device__ __forceinline__ void stage_rc(int b, int& R, int& C) { const int st = b / 1024, sb = b % 1024, swz = sb ^ (((sb >> 9) & 1) << 5); R = (st >> 1) * 16 + swz / 64; C = (st & 1) * 32 + (swz % 64) / 2; }
__host__ __device__ __forceinline__ int perm32(int rho) { const int n = rho >> 4, i = rho & 15; return 8 * (i >> 2) + 4 * n + (i & 3); }

struct Unit { const char* a; const char* b; int pm, pn, kind; };

struct TileOrder {
    int nM, nN, nwg;
    __device__ __forceinline__ void init(int nM_, int nN_) { nM = nM_; nN = nN_; nwg = nM * nN; }
    __device__ __forceinline__ bool tile(long L, int& pm, int& pn) const {
        if (L >= nwg) return false;
        int wgid = (int)L; { const int q = nwg / NXCD, r = nwg % NXCD, xcd = wgid % NXCD, off = wgid / NXCD; wgid = (xcd < r ? xcd * (q + 1) : r * (q + 1) + (xcd - r) * q) + off; }
        const int nig = WGM * nN, gid = wgid / nig, fm = gid * WGM, gsz = (nM - fm) < WGM ? (nM - fm) : WGM;
        pm = fm + ((wgid % nig) % gsz); pn = (wgid % nig) / gsz; return true;
    }
};

template <class Epi, class Sched>
__device__ __forceinline__ void gemm_phase(PG8_LAS unsigned char* lds, const int K, const Sched& S, const Epi& E) {
    const int tid = threadIdx.x, wid = __builtin_amdgcn_readfirstlane(tid >> 6), lane = tid & 63, wr = wid >> 2, wc = wid & 3, fr = lane & 15, fq = lane >> 4;
    const int nt = K / BK;
    unsigned voffA[2], voffB[2];
#pragma unroll
    for (int i = 0; i < 2; ++i) { int R, C; stage_rc(tid * 16 + i * 8192, R, C); const int Rb = (R & ~31) + perm32(R & 31);
        voffA[i] = (unsigned)(R * K + C) * 2u; voffB[i] = (unsigned)(Rb * K + C) * 2u; }
    const size_t kstep = (size_t)(BK * 2);
    const size_t hstep = (size_t)HALF * K * 2;
    const unsigned ldsw = (unsigned)wid * 1024u;
    const int aoff = lds_byte(wr * 64 + fr, fq * 8), boff = lds_byte(wc * 32 + fr, fq * 8);
#define PG8_SA(b, h) (((b) * 2 + (h)) * HTB)
#define PG8_SB(b, h) ((4 + (b) * 2 + (h)) * HTB)
#define PG8_STAGE(bufoff, gbase, voff) do { _Pragma("unroll") for (int _i = 0; _i < 2; ++_i) \
        __builtin_amdgcn_global_load_lds((const unsigned*)((const char*)(gbase) + (voff)[_i]), (PG8_LAS unsigned*)(lds + (bufoff) + ldsw + _i * 8192), 16, 0, 0); } while (0)
#define PG8_LDA(dst, b, h) do { _Pragma("unroll") for (int m = 0; m < 4; ++m) _Pragma("unroll") for (int k = 0; k < 2; ++k) dst[m][k] = *(const PG8_LAS bf16x8*)(lds + PG8_SA(b, h) + aoff + m * 2048 + k * 1024); } while (0)
#define PG8_LDB(dst, b, h) do { _Pragma("unroll") for (int n = 0; n < 2; ++n) _Pragma("unroll") for (int k = 0; k < 2; ++k) dst[n][k] = *(const PG8_LAS bf16x8*)(lds + PG8_SB(b, h) + boff + n * 2048 + k * 1024); } while (0)
#define PG8_MMA(ai, bj, At, Bt) do { __builtin_amdgcn_s_setprio(1); _Pragma("unroll") for (int m = 0; m < 4; ++m) _Pragma("unroll") for (int n = 0; n < 2; ++n) _Pragma("unroll") for (int k = 0; k < 2; ++k) \
        acc[ai][bj][m][n] = __builtin_amdgcn_mfma_f32_16x16x32_bf16(Bt[n][k], At[m][k], acc[ai][bj][m][n], 0, 0, 0); __builtin_amdgcn_s_setprio(0); } while (0)
#define PG8_WAIT_V(n) asm volatile("s_waitcnt vmcnt(" #n ")" ::: "memory")
#define PG8_WAIT_L(n) asm volatile("s_waitcnt lgkmcnt(" #n ")" ::: "memory")
#define PG8_BAR __builtin_amdgcn_s_barrier()
#define PG8_SCHED __builtin_amdgcn_sched_barrier(0)
    Unit cur, nxt; int ui = 0;
    if (!S.next(0, cur)) return;
    f32x4 acc[2][2][4][2];
#pragma unroll
    for (int a = 0; a < 2; ++a)
#pragma unroll
        for (int b = 0; b < 2; ++b)
#pragma unroll
            for (int m = 0; m < 4; ++m)
#pragma unroll
                for (int n = 0; n < 2; ++n) acc[a][b][m][n] = (f32x4){0.f, 0.f, 0.f, 0.f};
    bf16x8 At[4][2], B0[2][2], B1[2][2];
    const char* cA = cur.a; const char* cB = cur.b;
    PG8_STAGE(PG8_SB(0, 0), cB, voffB); PG8_STAGE(PG8_SB(0, 1), cB + hstep, voffB); PG8_STAGE(PG8_SA(0, 0), cA, voffA); PG8_STAGE(PG8_SA(0, 1), cA + hstep, voffA);
    if (wr == 1) PG8_BAR;
    PG8_WAIT_V(2); PG8_BAR;
    PG8_STAGE(PG8_SB(1, 0), cB + kstep, voffB); PG8_STAGE(PG8_SA(1, 0), cA + kstep, voffA); PG8_STAGE(PG8_SB(1, 1), cB + hstep + kstep, voffB);
    PG8_WAIT_V(6); PG8_BAR;
    for (;;) {
        const bool has_next = S.next(ui + 1, nxt);
        const char* nA = has_next ? nxt.a : cA; const char* nB = has_next ? nxt.b : cB;
        for (int t = 0; t < nt; t += 2) {
            const bool last = (t == nt - 2);
            const char* a1 = cA + (size_t)(t + 1) * kstep;
            const char* a2 = last ? nA : cA + (size_t)(t + 2) * kstep; const char* b2 = last ? nB : cB + (size_t)(t + 2) * kstep;
            const char* a3 = a2 + kstep; const char* b3 = b2 + kstep;
            PG8_LDB(B0, 0, 0); PG8_LDB(B1, 0, 1); PG8_SCHED; PG8_LDA(At, 0, 0); PG8_STAGE(PG8_SA(1, 1), a1 + hstep, voffA);
            PG8_WAIT_V(8); PG8_WAIT_L(0); PG8_BAR; PG8_MMA(0, 0, At, B0); PG8_MMA(0, 1, At, B1); PG8_BAR; PG8_SCHED;
            PG8_LDA(At, 0, 1); PG8_STAGE(PG8_SB(0, 0), b2, voffB); PG8_STAGE(PG8_SB(0, 1), b2 + hstep, voffB); PG8_STAGE(PG8_SA(0, 0), a2, voffA);
            PG8_WAIT_V(8); PG8_WAIT_L(0); PG8_BAR; PG8_MMA(1, 0, At, B0); PG8_MMA(1, 1, At, B1); PG8_BAR; PG8_SCHED;
            PG8_LDB(B0, 1, 0); PG8_LDB(B1, 1, 1); PG8_SCHED; PG8_LDA(At, 1, 0); PG8_STAGE(PG8_SA(0, 1), a2 + hstep, voffA);
            PG8_WAIT_V(8); PG8_WAIT_L(0); PG8_BAR; PG8_MMA(0, 0, At, B0); PG8_MMA(0, 1, At, B1); PG8_BAR; PG8_SCHED;
            PG8_LDA(At, 1, 1); PG8_STAGE(PG8_SB(1, 0), b3, voffB); PG8_STAGE(PG8_SB(1, 1), b3 + hstep, voffB); PG8_STAGE(PG8_SA(1, 0), a3, voffA);
            PG8_WAIT_V(8); PG8_WAIT_L(0); PG8_BAR; PG8_MMA(1, 0, At, B0); PG8_MMA(1, 1, At, B1); PG8_BAR; PG8_SCHED;
        }
        if (wr == 0) PG8_BAR;
        E(acc, cur, wr, wc, fr, fq);
        if (!has_next) break;
        if (!E.keep(cur)) {
#pragma unroll
        for (int a = 0; a < 2; ++a)
#pragma unroll
            for (int b = 0; b < 2; ++b)
#pragma unroll
                for (int m = 0; m < 4; ++m)
#pragma unroll
                    for (int n = 0; n < 2; ++n) acc[a][b][m][n] = (f32x4){0.f, 0.f, 0.f, 0.f};
        }
        cur = nxt; cA = nA; cB = nB; ++ui;
        if (wr == 1) PG8_BAR;
    }
    PG8_WAIT_V(0);
    PG8_BAR;
#undef PG8_SA
#undef PG8_SB
#undef PG8_STAGE
#undef PG8_LDA
#undef PG8_LDB
#undef PG8_MMA
#undef PG8_WAIT_V
#undef PG8_WAIT_L
#undef PG8_BAR
#undef PG8_SCHED
}
}

#define XB_TMO      128
#define XB_XCNT(j)  (256  + 64 * (j))
#define XB_XSUB(j)  (1280 + 64 * (j))
#define XB_XGEN(j)  (2304 + 64 * (j))
#define XB_TOP      3328
#define XB_TOPGEN   3392
#define XCD_BAR_WORDS 3456
#define XB_SPIN_CAP (1u << 18)
__device__ __forceinline__ unsigned xb_ld(unsigned* p)              { return __hip_atomic_load(p, __ATOMIC_RELAXED, __HIP_MEMORY_SCOPE_AGENT); }
__device__ __forceinline__ unsigned xb_add(unsigned* p, unsigned v) { return __hip_atomic_fetch_add(p, v, __ATOMIC_RELAXED, __HIP_MEMORY_SCOPE_AGENT); }
__device__ __forceinline__ unsigned xb_xcc_id() { return (unsigned)__builtin_amdgcn_s_getreg((3 << 11) | 20) & 0xFu; }
#define XB_SPIN(cond, bar) do { unsigned _sp = 0; while (cond) { __builtin_amdgcn_s_sleep(1); \
    if ((++_sp & 255u) == 0u) { if (xb_ld(&(bar)[XB_TMO])) break; if (_sp > XB_SPIN_CAP) { atomicAdd(&(bar)[XB_TMO], 1u); break; } } } } while (0)
struct XcdBarrier { unsigned* bar; unsigned x; volatile LAS unsigned* st; };
__device__ __forceinline__ XcdBarrier xcd_barrier_post(unsigned* bar, volatile LAS unsigned* st) {
    XcdBarrier b; b.bar = bar; b.x = xb_xcc_id(); b.st = st;
    if (threadIdx.x == 0) (void)xb_add(&bar[XB_XCNT(b.x)], 1u);
    return b;
}
__device__ __forceinline__ void xcd_barrier_complete(unsigned* bar, unsigned x, unsigned& nloc, unsigned& nx) {
    const unsigned G = gridDim.x * gridDim.y * gridDim.z;
    unsigned sum, cnt, mine, sp = 0u;
    for (;;) {
        sum = 0u; cnt = 0u; mine = 0u;
#pragma unroll
        for (unsigned j = 0; j < 16; ++j) { const unsigned c = xb_ld(&bar[XB_XCNT(j)]); sum += c; cnt += (c > 0u) ? 1u : 0u; mine = (j == x) ? c : mine; }
        if (sum == G) break;
        __builtin_amdgcn_s_sleep(1);
        if ((++sp & 255u) == 0u) { if (xb_ld(&bar[XB_TMO])) break; if (sp > XB_SPIN_CAP) { atomicAdd(&bar[XB_TMO], 1u); break; } }
    }
    nloc = mine > 0u ? mine : 1u; nx = cnt > 0u ? cnt : 1u;
}
__device__ __forceinline__ void xcd_barrier(const XcdBarrier& b) {
    asm volatile("s_waitcnt vmcnt(0)" ::: "memory");
    __syncthreads();
    if (threadIdx.x == 0) {
        unsigned* bar = b.bar;
        __builtin_amdgcn_s_waitcnt(0);
        unsigned nloc = b.st[0], nx = b.st[1];
        if (nloc == 0u) { xcd_barrier_complete(bar, b.x, nloc, nx); b.st[0] = nloc; b.st[1] = nx; }
        const unsigned old = xb_add(&bar[XB_XSUB(b.x)], 1u);
        const unsigned gen = old / nloc;
        if (old + 1u == (gen + 1u) * nloc) {
            __builtin_amdgcn_fence(__ATOMIC_RELEASE, "agent");
            asm volatile("s_waitcnt vmcnt(0)" ::: "memory");
            const unsigned og = xb_add(&bar[XB_TOP], 1u);
            const unsigned tg = og / nx;
            if (og + 1u == (tg + 1u) * nx) xb_add(&bar[XB_TOPGEN], 1u);
            else XB_SPIN(xb_ld(&bar[XB_TOPGEN]) == tg, bar);
            __builtin_amdgcn_fence(__ATOMIC_ACQUIRE, "agent");
            xb_add(&bar[XB_XGEN(b.x)], 1u);
            asm volatile("s_waitcnt vmcnt(0)" ::: "memory");
        } else {
            XB_SPIN(xb_ld(&bar[XB_XGEN(b.x)]) == gen, bar);
            __builtin_amdgcn_fence(__ATOMIC_ACQUIRE, "agent");
            asm volatile("s_waitcnt vmcnt(0)" ::: "memory");
        }
    }
    __syncthreads();
}

struct Args { const float* in[21]; float* out; unsigned char* ws; int ph_lo, ph_hi; };
struct Frame {
    LAS unsigned char* lds;
    int tid, lane, wave, vcu, G;
    const float* in[21]; float* out; unsigned char* ws;
};
__device__ __forceinline__ float wave_sum(float v) {
#pragma unroll
    for (int o = 1; o < 64; o <<= 1) v += __shfl_xor(v, o);
    return v;
}
__device__ __forceinline__ float wave_max(float v) {
#pragma unroll
    for (int o = 1; o < 64; o <<= 1) v = fmaxf(v, __shfl_xor(v, o));
    return v;
}

__device__ __forceinline__ void p0_transpose_item(const float* W, int ldw, int K, bf16* WT, int k0, int n0, int sc0, const float* kscale, LAS float* scr, int lane) {
#pragma unroll 8
    for (int i = 0; i < 32; ++i) { const int kk = 2 * i + (lane >> 5); float w = W[(size_t)(k0 + kk) * ldw + sc0 + (lane & 31)]; if (kscale) w *= kscale[k0 + kk]; scr[kk * 33 + (lane & 31)] = w; }
    LDS_WAIT(); asm volatile("" ::: "memory");
    const int c = lane & 7;
#pragma unroll
    for (int j = 0; j < 4; ++j) { const int n = (lane >> 3) + 8 * j; const LAS float* s = scr + (8 * c) * 33 + n;
        v4u o; o.x = pk2(s[0 * 33], s[1 * 33]); o.y = pk2(s[2 * 33], s[3 * 33]); o.z = pk2(s[4 * 33], s[5 * 33]); o.w = pk2(s[6 * 33], s[7 * 33]);
        *(GAS v4u*)(WT + (size_t)(n0 + n) * K + k0 + 8 * c) = o; }
    LDS_WAIT(); asm volatile("" ::: "memory");
}
__device__ __forceinline__ void rms_row_to_bf16(int lane, const float* xrow, const float* g, bf16* orow) {
    const GAS f32x4* xr = (const GAS f32x4*)xrow + lane;
    f32x4 v[4]; float s2 = 0.f;
#pragma unroll
    for (int j = 0; j < 4; ++j) { v[j] = xr[64 * j]; s2 += (v[j].x * v[j].x + v[j].y * v[j].y) + (v[j].z * v[j].z + v[j].w * v[j].w); }
    const float rstd = 1.f / sqrtf(wave_sum(s2) * (1.f / DM) + EPS);
    GAS unsigned long long* o8 = (GAS unsigned long long*)orow + lane;
#pragma unroll
    for (int j = 0; j < 4; ++j) { const f32x4 gg = ((const GAS f32x4*)g)[lane + 64 * j];
        o8[64 * j] = (unsigned long long)pk2(v[j].x * rstd * gg.x, v[j].y * rstd * gg.y) | ((unsigned long long)pk2(v[j].z * rstd * gg.z, v[j].w * rstd * gg.w) << 32); }
}
__device__ __forceinline__ void p0_prologue(Frame& F) {
    LAS float* scr = (LAS float*)(F.lds + F.wave * 16384);
    const int gw = F.vcu * NWAVES + F.wave, NGW = F.G * NWAVES;
    constexpr int I_IN = 16 * 176, I_A = 8 * 32, I_O = 16 * 32, I_GU = 16 * 176, I_D = 44 * 32;
    constexpr int NITEMS = I_IN + 2 * I_A + I_O + I_GU + I_D;
    for (int it = gw; it < NITEMS; it += NGW) {
        int r = it;
        if (r < I_IN) { const int kb = r / 176, nb = r % 176; p0_transpose_item(F.in[7], DIN, 1024, (bf16*)(F.ws + WS_WIN), 64 * kb, 32 * nb, 32 * nb, nullptr, scr, F.lane); continue; } r -= I_IN;
        if (r < I_A) { const int kb = r / 32, nb = r % 32; p0_transpose_item(F.in[11], DM, 512, (bf16*)(F.ws + WS_WA), 64 * kb, 32 * nb, 32 * nb, nullptr, scr, F.lane); continue; } r -= I_A;
        if (r < I_A) { const int kb = r / 32, nb = r % 32; p0_transpose_item(F.in[12], DM, 512, (bf16*)(F.ws + WS_WB), 64 * kb, 32 * nb, 32 * nb, nullptr, scr, F.lane); continue; } r -= I_A;
        if (r < I_O) { const int kb = r / 32, nb = r % 32; p0_transpose_item(F.in[13], DM, 1024, (bf16*)(F.ws + WS_WOUT), 64 * kb, 32 * nb, 32 * nb, nullptr, scr, F.lane); continue; } r -= I_O;
        if (r < I_GU) { const int kb = r / 176, nb = r % 176; const int n0 = 32 * nb, pn = n0 >> 8, bj = (n0 >> 7) & 1, jj = n0 & 127;
            p0_transpose_item(bj ? F.in[16] : F.in[15], DFF, 1024, (bf16*)(F.ws + WS_WGU), 64 * kb, n0, 128 * pn + jj, F.in[14], scr, F.lane); continue; } r -= I_GU;
        { const int kb = r / 32, nb = r % 32; p0_transpose_item(F.in[19], DM, DFF, (bf16*)(F.ws + WS_WD), 64 * kb, 32 * nb, 32 * nb, nullptr, scr, F.lane); }
    }
    bf16* H = (bf16*)(F.ws + WS_H);
    for (int m = gw; m < MPAD; m += NGW) {
        if (m < MP) rms_row_to_bf16(F.lane, F.in[0] + (size_t)m * DM, F.in[6], H + (size_t)m * DM);
        else if (m < MV) rms_row_to_bf16(F.lane, F.in[1] + (size_t)(m - MP) * DM, F.in[6], H + (size_t)m * DM);
        else { GAS v4u* o = (GAS v4u*)(H + (size_t)m * DM) + F.lane; o[0] = (v4u){0u, 0u, 0u, 0u}; o[64] = (v4u){0u, 0u, 0u, 0u}; }
    }
}

using pg8::Unit; using pg8::TileOrder;
struct PlainSched {
    TileOrder T; int G, c; const char* A; const char* Bt; size_t tstep;
    __device__ __forceinline__ bool next(int i, Unit& u) const { int pm, pn; if (!T.tile((long)i * G + c, pm, pn)) return false; u.pm = pm; u.pn = pn; u.kind = 0; u.a = A + (size_t)pm * tstep; u.b = Bt + (size_t)pn * tstep; return true; }
};
struct MergeSched {
    TileOrder T; int G, c; const char* A0; const char* A1; const char* B0; const char* B1; size_t tstep;
    __device__ __forceinline__ bool next(int i, Unit& u) const { int pm, pn; if (!T.tile((long)(i >> 1) * G + c, pm, pn)) return false; u.pm = pm; u.pn = pn; u.kind = i & 1;
        u.a = ((i & 1) ? A1 : A0) + (size_t)pm * tstep; u.b = ((i & 1) ? B1 : B0) + (size_t)pn * tstep; return true; }
};

#define EPI_ROW(u, ai, m) ((u).pm * 256 + (ai) * 128 + wr * 64 + (m) * 16 + fr)
#define EPI_COLT(bj) ((bj) * 128 + wc * 32 + fq * 8)

struct EpiIn {
    unsigned char* ws; const float* lbl; float* out;
    __device__ __forceinline__ bool keep(const Unit&) const { return false; }
    __device__ __forceinline__ void operator()(f32x4 (&acc)[2][2][4][2], const Unit& u, int wr, int wc, int fr, int fq) const {
        const int pn = u.pn;
        int seg, pn0;
        if (pn < 2) { seg = 0; pn0 = 0; } else if (pn < 4) { seg = 1; pn0 = 2; } else if (pn < 6) { seg = 2; pn0 = 4; } else if (pn < 8) { seg = 3; pn0 = 6; } else if (pn < 10) { seg = 4; pn0 = 8; }
        else if (pn < 12) { seg = 5; pn0 = 10; } else if (pn < 14) { seg = 6; pn0 = 12; } else if (pn < 18) { seg = 7; pn0 = 14; } else { seg = 8; pn0 = 18; }
        const int cseg0 = (pn - pn0) * 256;
        if (seg == 4) {
            float* LF = (float*)(ws + WS_LF);
#pragma unroll
            for (int bj = 0; bj < 2; ++bj) { const int cs = cseg0 + EPI_COLT(bj);
                float lb[8];
#pragma unroll
                for (int j = 0; j < 8; ++j) lb[j] = __builtin_amdgcn_rcpf(1.0f + fast_exp(lbl[512 + cs + j] - lbl[cs + j]));
#pragma unroll
                for (int ai = 0; ai < 2; ++ai)
#pragma unroll
                    for (int m = 0; m < 4; ++m) { const int row = EPI_ROW(u, ai, m); f32x4 o0, o1;
#pragma unroll
                        for (int j = 0; j < 4; ++j) { const float f0 = lb[j] + (1.0f - lb[j]) * fast_sigmoid(acc[ai][bj][m][0][j]); o0[j] = __builtin_amdgcn_logf(f0) * LN2;
                                                       const float f1 = lb[4 + j] + (1.0f - lb[4 + j]) * fast_sigmoid(acc[ai][bj][m][1][j]); o1[j] = __builtin_amdgcn_logf(f1) * LN2; }
                        float* p = LF + (size_t)row * 512 + cs; *(f32x4*)p = o0; *(f32x4*)(p + 4) = o1; } }
            return;
        }
        bf16* dst; int ld, act;
        switch (seg) {
            case 0: dst = (bf16*)(ws + WS_QA); ld = 512; act = 1; break;
            case 1: dst = (bf16*)(ws + WS_KA); ld = 512; act = 0; break;
            case 2: dst = (bf16*)(ws + WS_VA); ld = 512; act = 0; break;
            case 3: dst = (bf16*)(ws + WS_QB); ld = 512; act = 2; break;
            case 5: dst = (bf16*)(ws + WS_VB); ld = 512; act = 0; break;
            case 6: dst = (bf16*)(ws + WS_GB); ld = 512; act = 2; break;
            case 7: dst = (bf16*)(ws + WS_ZA); ld = 1024; act = 3; break;
            default: dst = (bf16*)(ws + WS_ZB); ld = 1024; act = 3; break;
        }
        const bool kvout = (seg == 1 || seg == 2) && (u.pm == 128 || (u.pm & 63) >= 62);
#pragma unroll
        for (int ai = 0; ai < 2; ++ai)
#pragma unroll
            for (int m = 0; m < 4; ++m) { const int row = EPI_ROW(u, ai, m);
#pragma unroll
                for (int bj = 0; bj < 2; ++bj) { const int cs = cseg0 + EPI_COLT(bj);
                    f32x4 v0 = acc[ai][bj][m][0], v1 = acc[ai][bj][m][1];
                    if (act == 1) { v0 = v0 * QSCALE; v1 = v1 * QSCALE; }
                    else if (act >= 2) {
#pragma unroll
                        for (int j = 0; j < 4; ++j) { const float s0 = fast_sigmoid(v0[j]), s1 = fast_sigmoid(v1[j]); v0[j] = (act == 2) ? v0[j] * s0 : s0; v1[j] = (act == 2) ? v1[j] * s1 : s1; } }
                    v4u w; w.x = pk2(v0[0], v0[1]); w.y = pk2(v0[2], v0[3]); w.z = pk2(v1[0], v1[1]); w.w = pk2(v1[2], v1[3]);
                    *(v4u*)(dst + (size_t)row * ld + cs) = w;
                    if (kvout) {
                        const int hh = cs >> 6, d = cs & 63; float* o = nullptr;
                        if (row < MP) { const int b = row >> 14, t = row & 16383; if (t >= SEQ - 512) o = out + (seg == 1 ? O_KP : O_VP) + ((size_t)(b * 8 + hh) * 512 + (t - (SEQ - 512))) * 64 + d; }
                        else if (row < MV) { const int bs = (row - MP) >> 4, ts = (row - MP) & 15; o = out + (seg == 1 ? O_KS : O_VS) + ((size_t)(bs * 8 + hh) * 16 + ts) * 64 + d; }
                        if (o) { *(f32x4*)o = v0; *(f32x4*)(o + 4) = v1; }
                    } } }
    }
};

struct EpiMerge {
    const bf16* ZA; const bf16* ZB; bf16* MG;
    __device__ __forceinline__ bool keep(const Unit& u) const { return u.kind == 0; }
    __device__ __forceinline__ void operator()(f32x4 (&acc)[2][2][4][2], const Unit& u, int wr, int wc, int fr, int fq) const {
#pragma unroll
        for (int ai = 0; ai < 2; ++ai)
#pragma unroll
            for (int m = 0; m < 4; ++m) { const int row = EPI_ROW(u, ai, m);
#pragma unroll
                for (int bj = 0; bj < 2; ++bj) { const size_t off = (size_t)row * 1024 + u.pn * 256 + EPI_COLT(bj);
                    const v4u zb = *(const v4u*)(ZB + off);
                    float gb[8] = {bflo(zb.x), bfhi(zb.x), bflo(zb.y), bfhi(zb.y), bflo(zb.z), bfhi(zb.z), bflo(zb.w), bfhi(zb.w)};
                    if (u.kind == 0) {
                        const v4u za = *(const v4u*)(ZA + off);
                        float ga[8] = {bflo(za.x), bfhi(za.x), bflo(za.y), bfhi(za.y), bflo(za.z), bfhi(za.z), bflo(za.w), bfhi(za.w)};
#pragma unroll
                        for (int j = 0; j < 4; ++j) { acc[ai][bj][m][0][j] *= ga[j] * __builtin_amdgcn_rcpf(gb[j]); acc[ai][bj][m][1][j] *= ga[4 + j] * __builtin_amdgcn_rcpf(gb[4 + j]); }
                    } else {
                        f32x4 v0 = acc[ai][bj][m][0], v1 = acc[ai][bj][m][1];
#pragma unroll
                        for (int j = 0; j < 4; ++j) { v0[j] *= gb[j]; v1[j] *= gb[4 + j]; }
                        v4u w; w.x = pk2(v0[0], v0[1]); w.y = pk2(v0[2], v0[3]); w.z = pk2(v1[0], v1[1]); w.w = pk2(v1[2], v1[3]);
                        *(v4u*)(MG + off) = w;
                    } } }
    }
};

template <bool DOWN> struct EpiRes {
    const float* xp; const float* xs; float* out; bf16* X1B; float* RS;
    __device__ __forceinline__ bool keep(const Unit&) const { return false; }
    __device__ __forceinline__ void operator()(f32x4 (&acc)[2][2][4][2], const Unit& u, int wr, int wc, int fr, int fq) const {
#pragma unroll
        for (int ai = 0; ai < 2; ++ai)
#pragma unroll
            for (int m = 0; m < 4; ++m) { const int row = EPI_ROW(u, ai, m); float ss = 0.f;
                const bool valid = row < MV;
#pragma unroll
                for (int bj = 0; bj < 2; ++bj) { const int col = u.pn * 256 + EPI_COLT(bj);
                    f32x4 v0 = acc[ai][bj][m][0], v1 = acc[ai][bj][m][1];
                    if (valid) {
                        const float* src = DOWN ? out + (size_t)row * DM + col : (row < MP ? xp + (size_t)row * DM + col : xs + (size_t)(row - MP) * DM + col);
                        v0 = v0 + *(const f32x4*)src; v1 = v1 + *(const f32x4*)(src + 4);
                        float* o = out + (size_t)row * DM + col; *(f32x4*)o = v0; *(f32x4*)(o + 4) = v1;
                    }
                    if (!DOWN) { v4u w; w.x = pk2(v0[0], v0[1]); w.y = pk2(v0[2], v0[3]); w.z = pk2(v1[0], v1[1]); w.w = pk2(v1[2], v1[3]); *(v4u*)(X1B + (size_t)row * DM + col) = w; }
                    ss += (v0[0] * v0[0] + v0[1] * v0[1]) + (v0[2] * v0[2] + v0[3] * v0[3]) + (v1[0] * v1[0] + v1[1] * v1[1]) + (v1[2] * v1[2] + v1[3] * v1[3]); }
                ss += __shfl_xor(ss, 16); ss += __shfl_xor(ss, 32);
                if (fq == 0) RS[(size_t)row * 16 + u.pn * 4 + wc] = ss; }
    }
};
__device__ __forceinline__ float row_rstd(const float* RS, int row) {
    const f32x4* p = (const f32x4*)(RS + (size_t)row * 16);
    const f32x4 a = p[0], b = p[1], c = p[2], d = p[3];
    const float s = ((a[0] + a[1]) + (a[2] + a[3])) + ((b[0] + b[1]) + (b[2] + b[3])) + ((c[0] + c[1]) + (c[2] + c[3])) + ((d[0] + d[1]) + (d[2] + d[3]));
    return 1.0f / sqrtf(s * (1.0f / DM) + EPS);
}

struct EpiGU {
    const float* RS; bf16* AB; bf16* UB;
    __device__ __forceinline__ bool keep(const Unit&) const { return false; }
    __device__ __forceinline__ void operator()(f32x4 (&acc)[2][2][4][2], const Unit& u, int wr, int wc, int fr, int fq) const {
#pragma unroll
        for (int ai = 0; ai < 2; ++ai)
#pragma unroll
            for (int m = 0; m < 4; ++m) { const int row = EPI_ROW(u, ai, m); const float rs = row_rstd(RS, row);
#pragma unroll
                for (int bj = 0; bj < 2; ++bj) { const size_t off = (size_t)row * DFF + u.pn * 128 + wc * 32 + fq * 8;
                    const f32x4 v0 = acc[ai][bj][m][0] * rs, v1 = acc[ai][bj][m][1] * rs;
                    v4u w; w.x = pk2(v0[0], v0[1]); w.y = pk2(v0[2], v0[3]); w.z = pk2(v1[0], v1[1]); w.w = pk2(v1[2], v1[3]);
                    *(v4u*)((bj ? UB : AB) + off) = w; } }
    }
};

__device__ __forceinline__ float dot8(const v4u q, const v4u k) {
    return (bflo(q.x) * bflo(k.x) + bfhi(q.x) * bfhi(k.x)) + (bflo(q.y) * bflo(k.y) + bfhi(q.y) * bfhi(k.y)) + (bflo(q.z) * bflo(k.z) + bfhi(q.z) * bfhi(k.z)) + (bflo(q.w) * bflo(k.w) + bfhi(q.w) * bfhi(k.w));
}
__device__ __forceinline__ float dot8f(const v4u q, const f32x4 k0, const f32x4 k1) {
    return (bflo(q.x) * k0[0] + bfhi(q.x) * k0[1]) + (bflo(q.y) * k0[2] + bfhi(q.y) * k0[3]) + (bflo(q.z) * k1[0] + bfhi(q.z) * k1[1]) + (bflo(q.w) * k1[2] + bfhi(q.w) * k1[3]);
}
template <bool SAMPLE>
__device__ __forceinline__ void attn_simple_row(Frame& F, int qrow, int h) {
    const bf16* QA = (const bf16*)(F.ws + WS_QA); const bf16* KA = (const bf16*)(F.ws + WS_KA); const bf16* VA = (const bf16*)(F.ws + WS_VA);
    bf16* OA = (bf16*)(F.ws + WS_QA);
    const float* bias = F.in[8] + h * NREL;
    const int lane = F.lane;
    v4u q8[8];
#pragma unroll
    for (int i = 0; i < 8; ++i) q8[i] = *(const v4u*)(QA + (size_t)qrow * 512 + 64 * h + 8 * i);
    int b, qpos, kbase, nk;
    if (!SAMPLE) { b = qrow >> 14; qpos = qrow & 16383; kbase = 64 * ((qpos >> 6) - 8); nk = 576; }
    else { b = (qrow - MP) >> 4; qpos = PAST + ((qrow - MP) & 15); kbase = PAST - 512; nk = 528; }
    LAS float* wsc = (LAS float*)(F.lds + 32768 + F.wave * 4096);
    float mx = -INFINITY;
#pragma unroll 1
    for (int r = 0; r < 9; ++r) {
        const int j = 64 * r + lane; float sc = -INFINITY;
        if (j < nk) {
            const int kpos = kbase + j;
            if (!SAMPLE) {
                if (kpos >= 0) { const bf16* kp = KA + ((size_t)b * SEQ + kpos) * 512 + 64 * h; float d = 0.f;
#pragma unroll
                    for (int i = 0; i < 8; ++i) d += dot8(q8[i], *(const v4u*)(kp + 8 * i));
                    int dd = qpos - kpos; dd = dd < -63 ? -63 : (dd > 128 ? 128 : dd); sc = d + bias[dd + 63] * LOG2E; }
            } else {
                float d = 0.f;
                if (j < 512) { const float* kp = F.in[2] + ((size_t)(b * 8 + h) * 512 + j) * 64;
#pragma unroll
                    for (int i = 0; i < 8; ++i) d += dot8f(q8[i], *(const f32x4*)(kp + 8 * i), *(const f32x4*)(kp + 8 * i + 4)); }
                else { const bf16* kp = KA + ((size_t)MP + b * 16 + (j - 512)) * 512 + 64 * h;
#pragma unroll
                    for (int i = 0; i < 8; ++i) d += dot8(q8[i], *(const v4u*)(kp + 8 * i)); }
                int dd = qpos - kpos; dd = dd < -63 ? -63 : (dd > 128 ? 128 : dd); sc = d + bias[dd + 63] * LOG2E;
            }
        }
        wsc[j] = sc; mx = fmaxf(mx, sc);
    }
    mx = wave_max(mx); float l = 0.f;
#pragma unroll 1
    for (int r = 0; r < 9; ++r) { const float p = __builtin_amdgcn_exp2f(wsc[64 * r + lane] - mx); wsc[64 * r + lane] = p; l += p; }
    l = wave_sum(l);
    LDS_WAIT();
    float o = 0.f;
    const int jlo = (!SAMPLE && kbase < 0) ? -kbase : 0;
#pragma unroll 4
    for (int j = jlo; j < nk; ++j) {
        const float p = wsc[j];
        float vv;
        if (!SAMPLE) vv = bf2f(VA[((size_t)b * SEQ + kbase + j) * 512 + 64 * h + lane]);
        else if (j < 512) vv = F.in[3][((size_t)(b * 8 + h) * 512 + j) * 64 + lane];
        else vv = bf2f(VA[((size_t)MP + b * 16 + (j - 512)) * 512 + 64 * h + lane]);
        o += p * vv;
    }
    o *= __builtin_amdgcn_rcpf(l);
    const unsigned ob = pk2(o, 0.f) & 0xffffu;
    OA[(size_t)qrow * 512 + 64 * h + lane] = (bf16)ob;
}


constexpr int AT_K0 = 0, AT_V0 = 9216, AT_BUF = 18432, AT_BIAS = 36864, AT_WS = 37888;
__device__ __forceinline__ void attn_unit(Frame& F, int unit) {
    const int bh = unit >> 6, qg = unit & 63, b = bh >> 3, h = bh & 7;
    const int tid = F.tid, lane = F.lane, wave = F.wave, hi = lane >> 5, l31 = lane & 31;
    const int ci = wave >> 1, cq = 4 * qg + ci, iq = 32 * (wave & 1) + l31;
    LAS unsigned char* L = F.lds;
    LAS float* biasL = (LAS float*)(L + AT_BIAS); LAS float* wsf = (LAS float*)(L + AT_WS) + wave * 64;
    if (tid < NREL) biasL[tid] = F.in[8][h * NREL + tid] * LOG2E;
    const bf16* QA = (const bf16*)(F.ws + WS_QA); const bf16* KA = (const bf16*)(F.ws + WS_KA); const bf16* VA = (const bf16*)(F.ws + WS_VA);
    bf16* OA = (bf16*)(F.ws + WS_QA);
    const size_t qrow = (size_t)b * SEQ + cq * 64 + iq;
    bf16x8 qr[4];
#pragma unroll
    for (int d0 = 0; d0 < 4; ++d0) qr[d0] = *(const bf16x8*)(QA + qrow * 512 + 64 * h + 16 * d0 + 8 * hi);
    const int j0 = (8 - 4 * qg) > 0 ? (8 - 4 * qg) : 0;
    const int vpos = (lane & ~15) | (8 * ((lane >> 2) & 1) + 4 * ((lane >> 3) & 1) + (lane & 3));
    v4u kreg, vreg;
#define AT_LOADG(j) do { const size_t rb = (size_t)b * SEQ + (size_t)(4 * qg - 8 + (j)) * 64; \
        kreg = *(const v4u*)(KA + (rb + (tid >> 3)) * 512 + 64 * h + 8 * (tid & 7)); vreg = *(const v4u*)(VA + (rb + lane) * 512 + 64 * h + 8 * wave); } while (0)
#define AT_STORE(buf) do { LAS unsigned char* B_ = L + (buf) * AT_BUF; *(LAS v4u*)(B_ + AT_K0 + (tid >> 3) * 144 + (tid & 7) * 16) = kreg; \
        LAS unsigned char* V_ = B_ + AT_V0 + (8 * wave) * 144 + 2 * vpos; \
        *(LAS unsigned short*)(V_ + 0 * 144) = (unsigned short)(vreg.x & 0xffffu); *(LAS unsigned short*)(V_ + 1 * 144) = (unsigned short)(vreg.x >> 16); \
        *(LAS unsigned short*)(V_ + 2 * 144) = (unsigned short)(vreg.y & 0xffffu); *(LAS unsigned short*)(V_ + 3 * 144) = (unsigned short)(vreg.y >> 16); \
        *(LAS unsigned short*)(V_ + 4 * 144) = (unsigned short)(vreg.z & 0xffffu); *(LAS unsigned short*)(V_ + 5 * 144) = (unsigned short)(vreg.z >> 16); \
        *(LAS unsigned short*)(V_ + 6 * 144) = (unsigned short)(vreg.w & 0xffffu); *(LAS unsigned short*)(V_ + 7 * 144) = (unsigned short)(vreg.w >> 16); } while (0)
    AT_LOADG(j0); AT_STORE(0);
    __syncthreads();
    float m_run = -INFINITY, l_run = 0.f; f32x16 o0 = {}, o1 = {};
    for (int j = j0; j < 12; ++j) {
        const int cur = (j - j0) & 1;
        if (j + 1 < 12) AT_LOADG(j + 1);
        if (j >= ci && j <= ci + 8) {
            const LAS unsigned char* Kb = L + cur * AT_BUF + AT_K0; const LAS unsigned char* Vb = L + cur * AT_BUF + AT_V0;
            const int dc = ci + 8 - j;
            f32x16 s0 = {}, s1 = {};
#pragma unroll
            for (int d0 = 0; d0 < 4; ++d0) {
                const bf16x8 k0 = *(const LAS bf16x8*)(Kb + l31 * 144 + (16 * d0 + 8 * hi) * 2);
                const bf16x8 k1 = *(const LAS bf16x8*)(Kb + (32 + l31) * 144 + (16 * d0 + 8 * hi) * 2);
                s0 = __builtin_amdgcn_mfma_f32_32x32x16_bf16(k0, qr[d0], s0, 0, 0, 0); s1 = __builtin_amdgcn_mfma_f32_32x32x16_bf16(k1, qr[d0], s1, 0, 0, 0);
            }
            if (dc >= 3) { const float bc = biasL[NREL - 1];
#pragma unroll
                for (int r = 0; r < 16; ++r) { s0[r] += bc; s1[r] += bc; } }
            else {
#pragma unroll
                for (int r = 0; r < 16; ++r) { int d = 64 * dc + iq - crow(r, hi); int d1 = d - 32;
                    d = d < -63 ? -63 : (d > 128 ? 128 : d); d1 = d1 < -63 ? -63 : (d1 > 128 ? 128 : d1);
                    s0[r] += biasL[d + 63]; s1[r] += biasL[d1 + 63]; } }
            float mx = fmaxf(s0[0], s1[0]);
#pragma unroll
            for (int r = 1; r < 16; ++r) mx = fmaxf(mx, fmaxf(s0[r], s1[r]));
            mx = fmaxf(mx, __shfl_xor(mx, 32));
            const float m_new = fmaxf(m_run, mx), alpha = __builtin_amdgcn_exp2f(m_run - m_new); m_run = m_new;
            float ps = 0.f;
#pragma unroll
            for (int r = 0; r < 16; ++r) { s0[r] = __builtin_amdgcn_exp2f(s0[r] - m_new); s1[r] = __builtin_amdgcn_exp2f(s1[r] - m_new); ps += s0[r] + s1[r]; }
            l_run = l_run * alpha + ps;
            if (hi == 0) wsf[l31] = alpha;
#pragma unroll
            for (int g = 0; g < 4; ++g) { const f32x4 a4 = *(const LAS f32x4*)(wsf + 8 * g + 4 * hi);
#pragma unroll
                for (int jj = 0; jj < 4; ++jj) { o0[4 * g + jj] *= a4[jj]; o1[4 * g + jj] *= a4[jj]; } }
#pragma unroll
            for (int s2 = 0; s2 < 2; ++s2) {
                v4u pw; pw.x = pk2(s0[8 * s2 + 0], s0[8 * s2 + 1]); pw.y = pk2(s0[8 * s2 + 2], s0[8 * s2 + 3]); pw.z = pk2(s0[8 * s2 + 4], s0[8 * s2 + 5]); pw.w = pk2(s0[8 * s2 + 6], s0[8 * s2 + 7]);
                const bf16x8 pa = __builtin_bit_cast(bf16x8, pw);
                const bf16x8 v0 = *(const LAS bf16x8*)(Vb + l31 * 144 + (16 * s2 + 8 * hi) * 2);
                const bf16x8 v1 = *(const LAS bf16x8*)(Vb + (32 + l31) * 144 + (16 * s2 + 8 * hi) * 2);
                o0 = __builtin_amdgcn_mfma_f32_32x32x16_bf16(pa, v0, o0, 0, 0, 0); o1 = __builtin_amdgcn_mfma_f32_32x32x16_bf16(pa, v1, o1, 0, 0, 0);
            }
#pragma unroll
            for (int s2 = 0; s2 < 2; ++s2) {
                v4u pw; pw.x = pk2(s1[8 * s2 + 0], s1[8 * s2 + 1]); pw.y = pk2(s1[8 * s2 + 2], s1[8 * s2 + 3]); pw.z = pk2(s1[8 * s2 + 4], s1[8 * s2 + 5]); pw.w = pk2(s1[8 * s2 + 6], s1[8 * s2 + 7]);
                const bf16x8 pa = __builtin_bit_cast(bf16x8, pw);
                const bf16x8 v0 = *(const LAS bf16x8*)(Vb + l31 * 144 + (32 + 16 * s2 + 8 * hi) * 2);
                const bf16x8 v1 = *(const LAS bf16x8*)(Vb + (32 + l31) * 144 + (32 + 16 * s2 + 8 * hi) * 2);
                o0 = __builtin_amdgcn_mfma_f32_32x32x16_bf16(pa, v0, o0, 0, 0, 0); o1 = __builtin_amdgcn_mfma_f32_32x32x16_bf16(pa, v1, o1, 0, 0, 0);
            }
        }
        if (j + 1 < 12) AT_STORE(cur ^ 1);
        __syncthreads();
    }
#undef AT_LOADG
#undef AT_STORE
    l_run += __shfl_xor(l_run, 32);
    if (hi == 0) wsf[l31] = __builtin_amdgcn_rcpf(l_run);
    const size_t orow0 = (size_t)b * SEQ + cq * 64 + 32 * (wave & 1);
#pragma unroll
    for (int g = 0; g < 4; ++g) { const f32x4 a4 = *(const LAS f32x4*)(wsf + 8 * g + 4 * hi);
#pragma unroll
        for (int jj = 0; jj < 4; ++jj) { const int r = 4 * g + jj; bf16* op = OA + (orow0 + crow(r, hi)) * 512 + 64 * h + l31; op[0] = bf1(o0[r] * a4[jj]); op[32] = bf1(o1[r] * a4[jj]); } }
    __syncthreads();
}

__device__ __forceinline__ void hgrn_simple(Frame& F, int row0, int L, int h, const float* S0, float* Sout) {
    const float* LF = (const float*)(F.ws + WS_LF); const bf16* QB = (const bf16*)(F.ws + WS_QB); const bf16* VB = (const bf16*)(F.ws + WS_VB); const bf16* GB = (const bf16*)(F.ws + WS_GB);
    bf16* OB = (bf16*)(F.ws + WS_QB);
    const float* gn = F.in[10];
    const int tid = F.tid, v = tid & 127, kg = __builtin_amdgcn_readfirstlane(tid >> 7);
    LAS float* opart = (LAS float*)F.lds;
    float S[32];
#pragma unroll
    for (int i = 0; i < 32; ++i) S[i] = S0 ? S0[(size_t)(32 * kg + i) * 128 + v] : 0.f;
    for (int t0 = 0; t0 < L; t0 += 16) {
        for (int tt = 0; tt < 16; ++tt) {
            const size_t row = (size_t)row0 + t0 + tt;
            const float* lf = LF + row * 512 + 128 * h + 32 * kg;
            const bf16* qp = QB + row * 512 + 128 * h + 32 * kg;
            const float vv = bf2f(VB[row * 512 + 128 * h + v]);
            float acc = 0.f;
#pragma unroll
            for (int i = 0; i < 32; ++i) { const float f = fast_exp(lf[i]); S[i] = f * S[i] + (1.0f - f) * vv; acc += bf2f(qp[i]) * S[i]; }
            opart[(tt * 4 + kg) * 128 + v] = acc;
        }
        __syncthreads();
        {
            const int tt = tid >> 5, v4 = (tid & 31) * 4; const size_t row = (size_t)row0 + t0 + tt;
            float o[4]; float ss = 0.f;
#pragma unroll
            for (int i = 0; i < 4; ++i) { o[i] = (opart[(tt * 4 + 0) * 128 + v4 + i] + opart[(tt * 4 + 1) * 128 + v4 + i]) + (opart[(tt * 4 + 2) * 128 + v4 + i] + opart[(tt * 4 + 3) * 128 + v4 + i]); ss += o[i] * o[i]; }
#pragma unroll
            for (int of = 1; of < 32; of <<= 1) ss += __shfl_xor(ss, of);
            const float rstd = 1.0f / sqrtf(ss * (1.0f / 128.0f) + EPS);
            const bf16* gp = GB + row * 512 + 128 * h + v4;
            float r[4];
#pragma unroll
            for (int i = 0; i < 4; ++i) r[i] = o[i] * rstd * gn[v4 + i] * bf2f(gp[i]);
            unsigned long long w = (unsigned long long)pk2(r[0], r[1]) | ((unsigned long long)pk2(r[2], r[3]) << 32);
            *(unsigned long long*)(OB + row * 512 + 128 * h + v4) = w;
        }
        __syncthreads();
    }
#pragma unroll
    for (int i = 0; i < 32; ++i) Sout[(size_t)(32 * kg + i) * 128 + v] = S[i];
}


constexpr int HA_KT = 0, HA_VT = 18432, HA_TOT = 36864;
__device__ __forceinline__ void hg_prefix(const float* LF, int row0, int h, int k, int tg, LAS float* tot, float (&lf)[16], float (&cs)[16], float& r1, float& r2, float& r3, float& bC) {
#pragma unroll
    for (int i = 0; i < 16; ++i) lf[i] = LF[(size_t)(row0 + 16 * tg + i) * 512 + 128 * h + k];
    float run = 0.f;
#pragma unroll
    for (int i = 0; i < 16; ++i) { run += lf[i]; cs[i] = run; }
    tot[tg * 128 + k] = run;
    __syncthreads();
    r1 = tot[k]; r2 = r1 + tot[128 + k]; r3 = r2 + tot[256 + k]; bC = r3 + tot[384 + k];
}
__device__ __forceinline__ void hg_load_vt(const bf16* VB, int row0, int h, int v, int tg, LAS unsigned char* VT) {
    unsigned short x[16];
#pragma unroll
    for (int i = 0; i < 16; ++i) x[i] = VB[(size_t)(row0 + 16 * tg + i) * 512 + 128 * h + v];
    v4u w0, w1;
    w0.x = x[0] | ((unsigned)x[1] << 16); w0.y = x[2] | ((unsigned)x[3] << 16); w0.z = x[4] | ((unsigned)x[5] << 16); w0.w = x[6] | ((unsigned)x[7] << 16);
    w1.x = x[8] | ((unsigned)x[9] << 16); w1.y = x[10] | ((unsigned)x[11] << 16); w1.z = x[12] | ((unsigned)x[13] << 16); w1.w = x[14] | ((unsigned)x[15] << 16);
    *(LAS v4u*)(VT + v * 144 + tg * 32) = w0; *(LAS v4u*)(VT + v * 144 + tg * 32 + 16) = w1;
}
__device__ __forceinline__ void hgrn_passA_item(Frame& F, int item) {
    const int c = item & 255, bh = item >> 8, b = bh >> 2, h = bh & 3, row0 = b * SEQ + c * 64;
    LAS unsigned char* L = F.lds; LAS float* tot = (LAS float*)(L + HA_TOT);
    const int k = F.tid & 127, tg = F.tid >> 7, lane = F.lane, hi = lane >> 5, l31 = lane & 31;
    float lf[16], cs[16], r1, r2, r3, bC;
    hg_prefix((const float*)(F.ws + WS_LF), row0, h, k, tg, tot, lf, cs, r1, r2, r3, bC);
    const float rown = tg == 0 ? 0.f : (tg == 1 ? r1 : (tg == 2 ? r2 : r3));
    unsigned kw[8];
#pragma unroll
    for (int i = 0; i < 16; i += 2) { const float e0 = (1.0f - fast_exp(lf[i])) * fast_exp(bC - (rown + cs[i])), e1 = (1.0f - fast_exp(lf[i + 1])) * fast_exp(bC - (rown + cs[i + 1])); kw[i >> 1] = pk2(e0, e1); }
    *(LAS v4u*)(L + HA_KT + k * 144 + tg * 32) = (v4u){kw[0], kw[1], kw[2], kw[3]}; *(LAS v4u*)(L + HA_KT + k * 144 + tg * 32 + 16) = (v4u){kw[4], kw[5], kw[6], kw[7]};
    hg_load_vt((const bf16*)(F.ws + WS_VB), row0, h, k, tg, L + HA_VT);
    if (tg == 0) ((float*)(F.ws + WS_DC))[(size_t)item * 128 + k] = fast_exp(bC);
    __syncthreads();
    const int vb = F.wave >> 1, kb0 = (F.wave & 1) * 2;
    f32x16 a0 = {}, a1 = {};
#pragma unroll
    for (int st = 0; st < 4; ++st) {
        const bf16x8 av = *(const LAS bf16x8*)(L + HA_VT + (32 * vb + l31) * 144 + (16 * st + 8 * hi) * 2);
        const bf16x8 b0 = *(const LAS bf16x8*)(L + HA_KT + (32 * kb0 + l31) * 144 + (16 * st + 8 * hi) * 2);
        const bf16x8 b1 = *(const LAS bf16x8*)(L + HA_KT + (32 * (kb0 + 1) + l31) * 144 + (16 * st + 8 * hi) * 2);
        a0 = __builtin_amdgcn_mfma_f32_32x32x16_bf16(av, b0, a0, 0, 0, 0); a1 = __builtin_amdgcn_mfma_f32_32x32x16_bf16(av, b1, a1, 0, 0, 0);
    }
    bf16* U = (bf16*)(F.ws + WS_US) + (size_t)item * 16384;
#pragma unroll
    for (int r = 0; r < 16; ++r) { const int v = 32 * vb + crow(r, hi); U[v * 128 + 32 * kb0 + l31] = bf1(a0[r]); U[v * 128 + 32 * (kb0 + 1) + l31] = bf1(a1[r]); }
    __syncthreads();
}
__device__ __forceinline__ void hgrn_scan(Frame& F) {
    for (int e = blockIdx.x * 512 + F.tid; e < 8 * 16384; e += F.G * 512) {
        const int bh = e >> 14, idx = e & 16383, k = idx & 127, v = idx >> 7;
        bf16* U = (bf16*)(F.ws + WS_US) + (size_t)bh * 256 * 16384 + idx; const float* D = (const float*)(F.ws + WS_DC) + (size_t)bh * 256 * 128 + k;
        float S = 0.f;
        for (int c = 0; c < 256; c += 8) {
            float u[8], d[8];
#pragma unroll
            for (int j = 0; j < 8; ++j) { u[j] = bf2f(U[(size_t)(c + j) * 16384]); d[j] = D[(c + j) * 128]; }
#pragma unroll
            for (int j = 0; j < 8; ++j) { U[(size_t)(c + j) * 16384] = bf1(S); S = d[j] * S + u[j]; }
        }
        F.out[O_HP + (size_t)bh * 16384 + k * 128 + v] = S;
    }
}
constexpr int HC_QE = 0, HC_QS = 17408, HC_KS = 34816, HC_ST = 78336, HC_VT = 113152, HC_AM = 131584, HC_TOT = 140800, HC_END = 142848, HC_OT = 0;
static_assert(HC_END <= LDSCTL_OFF, "pass C LDS map");
__device__ __forceinline__ void hgrn_passC_item(Frame& F, int item) {
    const int c = item & 255, bh = item >> 8, b = bh >> 2, h = bh & 3, row0 = b * SEQ + c * 64;
    LAS unsigned char* L = F.lds; LAS float* tot = (LAS float*)(L + HC_TOT);
    const int tid = F.tid, k = tid & 127, tg = tid >> 7, lane = F.lane, hi = lane >> 5, l31 = lane & 31;
    const bf16* QB = (const bf16*)(F.ws + WS_QB);
    {
        float lf[16], cs[16], r1, r2, r3, bC;
        hg_prefix((const float*)(F.ws + WS_LF), row0, h, k, tg, tot, lf, cs, r1, r2, r3, bC);
        const float rown = tg == 0 ? 0.f : (tg == 1 ? r1 : (tg == 2 ? r2 : r3));
        const float town = cs[15], rnext = rown + town;
        const float erow = fast_exp(rown);
        const float g1 = fast_exp(r1 - rnext), g2 = fast_exp(r2 - rnext), g3 = fast_exp(r3 - rnext);
        const int ksd = tg == 0 ? 0 : (tg == 1 ? 16 : (tg == 2 ? 48 : 96));
#pragma unroll
        for (int i = 0; i < 16; ++i) {
            const int s = 16 * tg + i;
            const float q = bf2f(QB[(size_t)(row0 + s) * 512 + 128 * h + k]);
            const float ec = fast_exp(cs[i]);
            const float qs = q * ec;
            *(LAS unsigned short*)(L + HC_QS + s * 272 + k * 2) = bf1(qs);
            *(LAS unsigned short*)(L + HC_QE + s * 272 + k * 2) = bf1(qs * erow);
            const float kk = 1.0f - fast_exp(lf[i]);
            *(LAS unsigned short*)(L + HC_KS + (ksd + s) * 272 + k * 2) = bf1(kk * fast_exp(fminf(-cs[i], 80.0f)));
            const float E = kk * fast_exp(town - cs[i]);
            if (tg < 1) *(LAS unsigned short*)(L + HC_KS + (16 + s) * 272 + k * 2) = bf1(E * g1);
            if (tg < 2) *(LAS unsigned short*)(L + HC_KS + (48 + s) * 272 + k * 2) = bf1(E * g2);
            if (tg < 3) *(LAS unsigned short*)(L + HC_KS + (96 + s) * 272 + k * 2) = bf1(E * g3);
        }
    }
    hg_load_vt((const bf16*)(F.ws + WS_VB), row0, h, k, tg, L + HC_VT);
    {
        const unsigned char* Sg = F.ws + WS_US + (size_t)item * 32768;
#pragma unroll
        for (int i = 0; i < 4; ++i) { const int idx = tid + 512 * i, row = idx >> 4, ch = idx & 15; *(LAS v4u*)(L + HC_ST + row * 272 + ch * 16) = *(const v4u*)(Sg + row * 256 + ch * 16); }
        for (int idx = tid; idx < 576; idx += 512) *(LAS v4u*)(L + HC_AM + idx * 16) = (v4u){0u, 0u, 0u, 0u};
    }
    __syncthreads();
    {
        const int fr = lane & 15, fq = lane >> 4;
        for (int bidx = F.wave; bidx < 10; bidx += 8) {
            const int i = bidx < 1 ? 0 : (bidx < 3 ? 1 : (bidx < 6 ? 2 : 3)), j = bidx - (i * (i + 1)) / 2;
            const int kso = i == 0 ? 0 : (i == 1 ? 16 : (i == 2 ? 48 : 96));
            f32x4 d = {0.f, 0.f, 0.f, 0.f};
#pragma unroll
            for (int st = 0; st < 4; ++st) {
                const bf16x8 a = *(const LAS bf16x8*)(L + HC_QS + (16 * i + fr) * 272 + (32 * st + 8 * fq) * 2);
                const bf16x8 bb = *(const LAS bf16x8*)(L + HC_KS + (kso + 16 * j + fr) * 272 + (32 * st + 8 * fq) * 2);
                d = __builtin_amdgcn_mfma_f32_16x16x32_bf16(a, bb, d, 0, 0, 0);
            }
#pragma unroll
            for (int r = 0; r < 4; ++r) { const int tt = 4 * fq + r; const float val = (i == j && fr > tt) ? 0.f : d[r];
                *(LAS unsigned short*)(L + HC_AM + (16 * i + tt) * 144 + (16 * j + fr) * 2) = bf1(val); }
        }
    }
    __syncthreads();
    f32x16 o = {};
    {
        const int tb = F.wave >> 2, vb = F.wave & 3;
#pragma unroll
        for (int st = 0; st < 8; ++st) {
            const bf16x8 a = *(const LAS bf16x8*)(L + HC_QE + (32 * tb + l31) * 272 + (16 * st + 8 * hi) * 2);
            const bf16x8 bb = *(const LAS bf16x8*)(L + HC_ST + (32 * vb + l31) * 272 + (16 * st + 8 * hi) * 2);
            o = __builtin_amdgcn_mfma_f32_32x32x16_bf16(a, bb, o, 0, 0, 0);
        }
#pragma unroll
        for (int st = 0; st < 4; ++st) {
            const bf16x8 a = *(const LAS bf16x8*)(L + HC_AM + (32 * tb + l31) * 144 + (16 * st + 8 * hi) * 2);
            const bf16x8 bb = *(const LAS bf16x8*)(L + HC_VT + (32 * vb + l31) * 144 + (16 * st + 8 * hi) * 2);
            o = __builtin_amdgcn_mfma_f32_32x32x16_bf16(a, bb, o, 0, 0, 0);
        }
        __syncthreads();
        LAS float* OT = (LAS float*)(L + HC_OT);
#pragma unroll
        for (int r = 0; r < 16; ++r) OT[(32 * tb + crow(r, hi)) * 132 + 32 * vb + l31] = o[r];
    }
    __syncthreads();
    {
        const LAS float* OT = (const LAS float*)(L + HC_OT);
        const int t = tid >> 3, vc = (tid & 7) * 16; const size_t row = (size_t)row0 + t;
        f32x4 x[4]; float ss = 0.f;
#pragma unroll
        for (int q = 0; q < 4; ++q) { x[q] = *(const LAS f32x4*)(OT + t * 132 + vc + 4 * q); ss += (x[q][0] * x[q][0] + x[q][1] * x[q][1]) + (x[q][2] * x[q][2] + x[q][3] * x[q][3]); }
        ss += __shfl_xor(ss, 1); ss += __shfl_xor(ss, 2); ss += __shfl_xor(ss, 4);
        const float rstd = 1.0f / sqrtf(ss * (1.0f / 128.0f) + EPS);
        const bf16* GB = (const bf16*)(F.ws + WS_GB); bf16* OB = (bf16*)(F.ws + WS_QB); const float* gn = F.in[10];
        const v4u g0 = *(const v4u*)(GB + row * 512 + 128 * h + vc), g1 = *(const v4u*)(GB + row * 512 + 128 * h + vc + 8);
        const float gg[16] = {bflo(g0.x), bfhi(g0.x), bflo(g0.y), bfhi(g0.y), bflo(g0.z), bfhi(g0.z), bflo(g0.w), bfhi(g0.w), bflo(g1.x), bfhi(g1.x), bflo(g1.y), bfhi(g1.y), bflo(g1.z), bfhi(g1.z), bflo(g1.w), bfhi(g1.w)};
        float y[16];
#pragma unroll
        for (int q = 0; q < 4; ++q)
#pragma unroll
            for (int j = 0; j < 4; ++j) y[4 * q + j] = x[q][j] * rstd * gn[vc + 4 * q + j] * gg[4 * q + j];
        v4u w0, w1; w0.x = pk2(y[0], y[1]); w0.y = pk2(y[2], y[3]); w0.z = pk2(y[4], y[5]); w0.w = pk2(y[6], y[7]); w1.x = pk2(y[8], y[9]); w1.y = pk2(y[10], y[11]); w1.z = pk2(y[12], y[13]); w1.w = pk2(y[14], y[15]);
        *(v4u*)(OB + row * 512 + 128 * h + vc) = w0; *(v4u*)(OB + row * 512 + 128 * h + vc + 8) = w1;
    }
    __syncthreads();
}

__device__ __forceinline__ float gelu_tanh(float x) { const float z = 1.5957691216057308f * (x + 0.044715f * x * x * x); return x * __builtin_amdgcn_rcpf(1.0f + __builtin_amdgcn_exp2f(-z * LOG2E)); }
__device__ __forceinline__ void conv_phase(Frame& F) {
    const bf16* AB = (const bf16*)(F.ws + WS_AB); bf16* UB = (bf16*)(F.ws + WS_UB);
    const float* cw = F.in[17]; const float* cb = F.in[18]; const float* st = F.in[5];
    const int gt = F.vcu * 512 + F.tid, NT = F.G * 512;
    constexpr int CPR = DFF / 8;
    for (long it = gt; it < (long)MV * CPR; it += NT) {
        const int row = (int)(it / CPR), c8 = (int)(it % CPR) * 8;
        int t, L; if (row < MP) { t = row & 16383; L = 0; } else { t = (row - MP) & 15; L = 1; }
        float a0[8], a1[8], a2[8];
        { const v4u w = *(const v4u*)(AB + (size_t)row * DFF + c8); a2[0] = bflo(w.x); a2[1] = bfhi(w.x); a2[2] = bflo(w.y); a2[3] = bfhi(w.y); a2[4] = bflo(w.z); a2[5] = bfhi(w.z); a2[6] = bflo(w.w); a2[7] = bfhi(w.w); }
        if (t >= 1) { const v4u w = *(const v4u*)(AB + (size_t)(row - 1) * DFF + c8); a1[0] = bflo(w.x); a1[1] = bfhi(w.x); a1[2] = bflo(w.y); a1[3] = bfhi(w.y); a1[4] = bflo(w.z); a1[5] = bfhi(w.z); a1[6] = bflo(w.w); a1[7] = bfhi(w.w); }
        else { if (L) { const float* p = st + ((size_t)((row - MP) >> 4) * 2 + 1) * DFF + c8;
#pragma unroll
                for (int j = 0; j < 8; ++j) a1[j] = p[j]; } else {
#pragma unroll
                for (int j = 0; j < 8; ++j) a1[j] = 0.f; } }
        if (t >= 2) { const v4u w = *(const v4u*)(AB + (size_t)(row - 2) * DFF + c8); a0[0] = bflo(w.x); a0[1] = bfhi(w.x); a0[2] = bflo(w.y); a0[3] = bfhi(w.y); a0[4] = bflo(w.z); a0[5] = bfhi(w.z); a0[6] = bflo(w.w); a0[7] = bfhi(w.w); }
        else { if (L) { const float* p = st + ((size_t)((row - MP) >> 4) * 2 + t) * DFF + c8;
#pragma unroll
                for (int j = 0; j < 8; ++j) a0[j] = p[j]; } else {
#pragma unroll
                for (int j = 0; j < 8; ++j) a0[j] = 0.f; } }
        const v4u uw = *(const v4u*)(UB + (size_t)row * DFF + c8);
        float uu[8] = {bflo(uw.x), bfhi(uw.x), bflo(uw.y), bfhi(uw.y), bflo(uw.z), bfhi(uw.z), bflo(uw.w), bfhi(uw.w)};
        float g[8];
#pragma unroll
        for (int j = 0; j < 8; ++j) { const float ac = cb[c8 + j] + cw[c8 + j] * a0[j] + cw[DFF + c8 + j] * a1[j] + cw[2 * DFF + c8 + j] * a2[j]; g[j] = gelu_tanh(ac) * uu[j]; }
        v4u w; w.x = pk2(g[0], g[1]); w.y = pk2(g[2], g[3]); w.z = pk2(g[4], g[5]); w.w = pk2(g[6], g[7]);
        *(v4u*)(UB + (size_t)row * DFF + c8) = w;
        if (!L && t >= SEQ - 2) { float* o = F.out + O_CP + ((size_t)(row >> 14) * 2 + (t - (SEQ - 2))) * DFF + c8;
#pragma unroll
            for (int j = 0; j < 8; ++j) o[j] = a2[j]; }
        if (L && t >= DSEQ - 2) { float* o = F.out + O_CS + ((size_t)((row - MP) >> 4) * 2 + (t - (DSEQ - 2))) * DFF + c8;
#pragma unroll
            for (int j = 0; j < 8; ++j) o[j] = a2[j]; }
    }
}
__device__ __forceinline__ void final_norm_phase(Frame& F) {
    const float* RS = (const float*)(F.ws + WS_RS2); const float* g = F.in[20];
    const int gw = F.vcu * NWAVES + F.wave, NGW = F.G * NWAVES;
    for (int m = gw; m < MV; m += NGW) {
        const float rs = row_rstd(RS, m);
        GAS f32x4* xr = (GAS f32x4*)(F.out + (size_t)m * DM) + F.lane;
#pragma unroll
        for (int j = 0; j < 4; ++j) { const f32x4 gg = ((const GAS f32x4*)g)[F.lane + 64 * j]; f32x4 v = xr[64 * j]; v = v * rs * gg; xr[64 * j] = v; }
    }
}

constexpr int N_PHASES = 11;
__global__ void __launch_bounds__(NWAVES * 64, 2) mk_fwd(Args args) {
    extern __shared__ __attribute__((aligned(16))) unsigned char lds[];
    Frame F;
    F.lds = (LAS unsigned char*)lds;
    F.tid = threadIdx.x; F.lane = F.tid & 63; F.wave = __builtin_amdgcn_readfirstlane(F.tid >> 6);
    F.G = gridDim.x; { const int bx = blockIdx.x; F.vcu = (F.G % 8 == 0) ? (bx % 8) * (F.G / 8) + bx / 8 : bx; }
#pragma unroll
    for (int i = 0; i < 21; ++i) F.in[i] = args.in[i];
    F.out = args.out; F.ws = args.ws;
    for (int u = F.tid; u < (LDS_BYTES - LDSCTL_OFF) / 4; u += NWAVES * 64) ((LAS unsigned*)(F.lds + LDSCTL_OFF))[u] = 0u;
    __syncthreads();
    gu32* ctl = (gu32*)(F.ws + WS_CTL);
    XcdBarrier bar; bar.bar = (unsigned*)(ctl + CW_BAR); bar.x = 0; bar.st = nullptr;
    if (MK_N_LAUNCHES == 1) bar = xcd_barrier_post((unsigned*)(ctl + CW_BAR), (volatile LAS unsigned*)(F.lds + MISC_OFF) + 8);
    const int lo = args.ph_lo, hi = args.ph_hi;
#ifndef PHMASK
#define PHMASK 0xffff
#endif
#define IN(k) (((PHMASK >> (k)) & 1) && lo <= (k) && (k) < hi)
#define SEAM(k) do { if (IN(k) && IN((k) + 1)) xcd_barrier(bar); } while (0)

    if (IN(0)) { p0_prologue(F); }
    SEAM(0);
    if (IN(1)) {
        PlainSched S; S.T.init(MPAD / 256, DIN / 256); S.G = F.G; S.c = (int)blockIdx.x; S.A = (const char*)(F.ws + WS_H); S.Bt = (const char*)(F.ws + WS_WIN); S.tstep = (size_t)256 * 1024 * 2;
        EpiIn E{F.ws, F.in[9], F.out};
        pg8::gemm_phase(F.lds, 1024, S, E);
    }
    SEAM(1);
    if (IN(2)) {
        for (int it = F.vcu; it < 2048; it += F.G) hgrn_passA_item(F, it);
        if (blockIdx.x < 32) { const int i = blockIdx.x, b = i >> 2, h = i & 3; hgrn_simple(F, MP + b * DSEQ, DSEQ, h, F.in[4] + (size_t)(b * 4 + h) * 16384, F.out + O_HS + (size_t)(b * 4 + h) * 16384); }
        const int gw = F.vcu * NWAVES + F.wave, NGW = F.G * NWAVES;
        for (int it = gw; it < MS * NHA; it += NGW) { const int qrow = MP + (it >> 3), h = it & 7; attn_simple_row<true>(F, qrow, h); }
        __syncthreads();
        for (int it = F.vcu; it < 1024; it += F.G) attn_unit(F, it);
    }
    SEAM(2);
    if (IN(3)) { hgrn_scan(F); }
    SEAM(3);
    if (IN(4)) { for (int it = F.vcu; it < 2048; it += F.G) hgrn_passC_item(F, it); }
    SEAM(4);
    if (IN(5)) {
        MergeSched S; S.T.init(MPAD / 256, DM / 256); S.G = F.G; S.c = (int)blockIdx.x; S.A0 = (const char*)(F.ws + WS_QA); S.A1 = (const char*)(F.ws + WS_QB);
        S.B0 = (const char*)(F.ws + WS_WA); S.B1 = (const char*)(F.ws + WS_WB); S.tstep = (size_t)256 * 512 * 2;
        EpiMerge E{(const bf16*)(F.ws + WS_ZA), (const bf16*)(F.ws + WS_ZB), (bf16*)(F.ws + WS_MG)};
        pg8::gemm_phase(F.lds, 512, S, E);
    }
    SEAM(5);
    if (IN(6)) {
        PlainSched S; S.T.init(MPAD / 256, DM / 256); S.G = F.G; S.c = (int)blockIdx.x; S.A = (const char*)(F.ws + WS_MG); S.Bt = (const char*)(F.ws + WS_WOUT); S.tstep = (size_t)256 * 1024 * 2;
        EpiRes<false> E{F.in[0], F.in[1], F.out, (bf16*)(F.ws + WS_X1B), (float*)(F.ws + WS_RS1)};
        pg8::gemm_phase(F.lds, 1024, S, E);
    }
    SEAM(6);
    if (IN(7)) {
        PlainSched S; S.T.init(MPAD / 256, DIN / 256); S.G = F.G; S.c = (int)blockIdx.x; S.A = (const char*)(F.ws + WS_X1B); S.Bt = (const char*)(F.ws + WS_WGU); S.tstep = (size_t)256 * 1024 * 2;
        EpiGU E{(const float*)(F.ws + WS_RS1), (bf16*)(F.ws + WS_AB), (bf16*)(F.ws + WS_UB)};
        pg8::gemm_phase(F.lds, 1024, S, E);
    }
    SEAM(7);
    if (IN(8)) { conv_phase(F); }
    SEAM(8);
    if (IN(9)) {
        PlainSched S; S.T.init(MPAD / 256, DM / 256); S.G = F.G; S.c = (int)blockIdx.x; S.A = (const char*)(F.ws + WS_UB); S.Bt = (const char*)(F.ws + WS_WD); S.tstep = (size_t)256 * DFF * 2;
        EpiRes<true> E{nullptr, nullptr, F.out, nullptr, (float*)(F.ws + WS_RS2)};
        pg8::gemm_phase(F.lds, DFF, S, E);
    }
    SEAM(9);
    if (IN(10)) { final_norm_phase(F); }
#undef IN
#undef SEAM
}

extern "C" void kernel_launch(void* const* d_in, const int* in_sizes, int n_in, void* d_out, int out_size, void* d_ws, size_t ws_size, hipStream_t stream) {
    static int grid = 0;
    if (grid == 0) {
        if (n_in != 21 || out_size != (int)O_END || ws_size < WS_END) { fprintf(stderr, "kernel_launch: unexpected shapes: n_in %d out %d ws %zu (need %zu)\n", n_in, out_size, ws_size, (size_t)WS_END); grid = -1; return; }
        int dev = 0, cus = 0, per_cu = 0;
        if (hipGetDevice(&dev) != hipSuccess || hipDeviceGetAttribute(&cus, hipDeviceAttributeMultiprocessorCount, dev) != hipSuccess) { grid = -1; return; }
        if (hipFuncSetAttribute((const void*)mk_fwd, hipFuncAttributeMaxDynamicSharedMemorySize, LDS_BYTES) != hipSuccess) { fprintf(stderr, "kernel_launch: hipFuncSetAttribute failed\n"); grid = -1; return; }
        if (hipOccupancyMaxActiveBlocksPerMultiprocessor(&per_cu, (const void*)mk_fwd, NWAVES * 64, LDS_BYTES) != hipSuccess || per_cu < 1) fprintf(stderr, "kernel_launch: occupancy query says %d\n", per_cu);
        (void)hipGetLastError();
        grid = cus;
    }
    if (grid < 0) return;
    (void)hipMemsetAsync((char*)d_ws + WS_CTL, 0, CTL_ZERO_BYTES, stream);
    Args a{};
    for (int i = 0; i < 21; ++i) a.in[i] = (const float*)d_in[i];
    a.out = (float*)d_out; a.ws = (unsigned char*)d_ws;
    if (MK_N_LAUNCHES == 1) { a.ph_lo = 0; a.ph_hi = N_PHASES; hipLaunchKernelGGL(mk_fwd, dim3(grid), dim3(NWAVES * 64), LDS_BYTES, stream, a); }
    else { for (int p = 0; p < N_PHASES; ++p) { a.ph_lo = p; a.ph_hi = p + 1; hipLaunchKernelGGL(mk_fwd, dim3(grid), dim3(NWAVES * 64), LDS_BYTES, stream, a); } }
}
```

```cpp
#include <hip/hip_runtime.h>
#include <cstdio>
#include <cstdint>

#ifndef MK_N_LAUNCHES
#define MK_N_LAUNCHES 1
#endif

constexpr int DM = 1024, NBATCH = 2, SEQ = 16384, DBATCH = 8, DSEQ = 16, PAST = 4096;
constexpr int MP = NBATCH * SEQ;
constexpr int MS = DBATCH * DSEQ;
constexpr int MV = MP + MS;
constexpr int MPAD = 33024;
constexpr int DIN = 5632, DFF = 2816, DA = 512;
constexpr int NHA = 8, NHB = 4;
constexpr int NREL = 192;
constexpr float EPS = 1e-6f;
constexpr float LOG2E = 1.4426950408889634f;
constexpr float LN2 = 0.6931471805599453f;
constexpr float QSCALE = 0.125f * LOG2E;

constexpr size_t O_Y = 0, O_KP = 33685504, O_VP = 34209792, O_HP = 34734080, O_CP = 34865152, O_KS = 34876416, O_VS = 34941952, O_HS = 35007488, O_CS = 35531776, O_END = 35576832;

constexpr size_t MiB = 1u << 20;
constexpr size_t WS_CTL = 0, CTL_ZERO_BYTES = 1 * MiB;
constexpr size_t WS_WIN = 2 * MiB, WS_WA = 13 * MiB, WS_WB = 14 * MiB, WS_WOUT = 15 * MiB, WS_WGU = 17 * MiB, WS_WD = 28 * MiB;
constexpr size_t WS_RS1 = 34 * MiB, WS_RS2 = 37 * MiB;
constexpr size_t SZ_R512 = (size_t)MPAD * 512 * 2, SZ_R1024 = (size_t)MPAD * 1024 * 2;
constexpr size_t WS_H = 40 * MiB;
constexpr size_t WS_QA = 105 * MiB, WS_KA = WS_QA + SZ_R512, WS_VA = WS_KA + SZ_R512, WS_QB = WS_VA + SZ_R512, WS_VB = WS_QB + SZ_R512, WS_GB = WS_VB + SZ_R512;
constexpr size_t WS_LF = WS_GB + SZ_R512;
constexpr size_t WS_ZA = WS_LF + SZ_R1024, WS_ZB = WS_ZA + SZ_R1024;
constexpr size_t WS_DC = WS_ZB + SZ_R1024;
constexpr size_t WS_END = WS_DC + 1 * MiB;
constexpr size_t WS_MG = WS_KA;
constexpr size_t WS_X1B = WS_H;
constexpr size_t WS_US = WS_H;
constexpr size_t SZ_FF = (size_t)MPAD * DFF * 2;
constexpr size_t WS_G = WS_QA;
constexpr size_t WS_ST = WS_LF;
constexpr size_t WS_SAB = WS_ZA, WS_SUB = WS_ZA + 1 * MiB;
static_assert(WS_G + SZ_FF <= WS_ST && WS_ST + (size_t)512 * 6 * DFF * 4 <= WS_SAB && WS_END <= 512 * MiB, "d_ws map");

constexpr size_t DO_OA = 0, DO_OB = SZ_R512;
constexpr int CW_TMO = 0, CW_BAR = 4096;
#ifndef PROBE_DUP
#define PROBE_DUP -1
#endif

constexpr int RING_BYTES = 131072, LDS_BYTES = 163840, LDSCTL_OFF = LDS_BYTES - 512, MISC_OFF = LDSCTL_OFF + 320;
constexpr int NWAVES = 8;

#define GAS __attribute__((address_space(1)))
#define LAS __attribute__((address_space(3)))
typedef unsigned short bf16;
typedef unsigned v4u __attribute__((ext_vector_type(4)));
typedef float f32x4 __attribute__((ext_vector_type(4)));
typedef float f32x2 __attribute__((ext_vector_type(2)));
typedef __bf16 bf16x2_t __attribute__((ext_vector_type(2)));
typedef short bf16x8 __attribute__((ext_vector_type(8)));
typedef GAS unsigned gu32;
#define RLX_AGENT __ATOMIC_RELAXED, __HIP_MEMORY_SCOPE_AGENT
#define LDS_WAIT() asm volatile("s_waitcnt lgkmcnt(0)" ::: "memory")
#define VM_WAIT() asm volatile("s_waitcnt vmcnt(0)" ::: "memory")

__device__ __forceinline__ unsigned pk2(float lo, float hi) { f32x2 v = {lo, hi}; bf16x2_t b = __builtin_convertvector(v, bf16x2_t); return __builtin_bit_cast(unsigned, b); }
typedef float f32x16 __attribute__((ext_vector_type(16)));
__device__ __forceinline__ int crow(int r, int hi) { return (r & 3) + 8 * (r >> 2) + 4 * hi; }
__device__ __forceinline__ unsigned short bf1(float x) { return (unsigned short)(pk2(x, x) & 0xffffu); }
__device__ __forceinline__ float bf2f(unsigned short x) { return __uint_as_float((unsigned)x << 16); }
__device__ __forceinline__ float bflo(unsigned w) { return __uint_as_float(w << 16); }
__device__ __forceinline__ float bfhi(unsigned w) { return __uint_as_float(w & 0xffff0000u); }
__device__ __forceinline__ float fast_sigmoid(float x) { return __builtin_amdgcn_rcpf(1.0f + __builtin_amdgcn_exp2f(-x * LOG2E)); }
__device__ __forceinline__ float fast_exp(float x) { return __builtin_amdgcn_exp2f(x * LOG2E); }

namespace pg8 {
#define PG8_LAS __attribute__((address_space(3)))
typedef unsigned short bf16_t;
constexpr int BM = 256, BK = 64, HALF = 128, HTB = HALF * BK * 2, STAGE_BYTES = 8 * HTB, NXCD = 8, WGM = 8;
__host__ __device__ __forceinline__ int lds_byte(int r, int c) { const int st = (r >> 4) * 2 + (c >> 5), rr = r & 15, cc = c & 31, ob = rr * 64 + cc * 2; return st * 1024 + (ob ^ (((ob >> 9) & 1) << 5)); }
__host__ __device__ __forceinline__ void stage_rc(int b, int& R, int& C) { const int st = b / 1024, sb = b % 1024, swz = sb ^ (((sb >> 9) & 1) << 5); R = (st >> 1) * 16 + swz / 64; C = (st & 1) * 32 + (swz % 64) / 2; }
__host__ __device__ __forceinline__ int perm32(int rho) { const int n = rho >> 4, i = rho & 15; return 8 * (i >> 2) + 4 * n + (i & 3); }

struct Unit { const char* a; const char* b; int pm, pn, kind, idx; };

struct TileOrder {
    int nM, nN, nwg;
    __device__ __forceinline__ void init(int nM_, int nN_) { nM = nM_; nN = nN_; nwg = nM * nN; }
    __device__ __forceinline__ bool tile(long L, int& pm, int& pn) const {
        if (L >= nwg) return false;
        int wgid = (int)L; { const int q = nwg / NXCD, r = nwg % NXCD, xcd = wgid % NXCD, off = wgid / NXCD; wgid = (xcd < r ? xcd * (q + 1) : r * (q + 1) + (xcd - r) * q) + off; }
        const int nig = WGM * nN, gid = wgid / nig, fm = gid * WGM, gsz = (nM - fm) < WGM ? (nM - fm) : WGM;
        pm = fm + ((wgid % nig) % gsz); pn = (wgid % nig) / gsz; return true;
    }
};

template <class Epi, class Sched>
__device__ __forceinline__ void gemm_phase(PG8_LAS unsigned char* lds, const int K, const Sched& S, const Epi& E) {
    const int tid = threadIdx.x, wid = __builtin_amdgcn_readfirstlane(tid >> 6), lane = tid & 63, wr = wid >> 2, wc = wid & 3, fr = lane & 15, fq = lane >> 4;
    const int nt = K / BK;
    unsigned voffA[2], voffB[2];
#pragma unroll
    for (int i = 0; i < 2; ++i) { int R, C; stage_rc(tid * 16 + i * 8192, R, C); const int Rb = (R & ~31) + perm32(R & 31);
        voffA[i] = (unsigned)(R * K + C) * 2u; voffB[i] = (unsigned)(Rb * K + C) * 2u; }
    const size_t kstep = (size_t)(BK * 2);
    const size_t hstep = (size_t)HALF * K * 2;
    const unsigned ldsw = (unsigned)wid * 1024u;
    const int aoff = lds_byte(wr * 64 + fr, fq * 8), boff = lds_byte(wc * 32 + fr, fq * 8);
#define PG8_SA(b, h) (((b) * 2 + (h)) * HTB)
#define PG8_SB(b, h) ((4 + (b) * 2 + (h)) * HTB)
#define PG8_STAGE(bufoff, gbase, voff) do { _Pragma("unroll") for (int _i = 0; _i < 2; ++_i) \
        __builtin_amdgcn_global_load_lds((const unsigned*)((const char*)(gbase) + (voff)[_i]), (PG8_LAS unsigned*)(lds + (bufoff) + ldsw + _i * 8192), 16, 0, 0); } while (0)
#define PG8_LDA(dst, b, h) do { _Pragma("unroll") for (int m = 0; m < 4; ++m) _Pragma("unroll") for (int k = 0; k < 2; ++k) dst[m][k] = *(const PG8_LAS bf16x8*)(lds + PG8_SA(b, h) + aoff + m * 2048 + k * 1024); } while (0)
#define PG8_LDB(dst, b, h) do { _Pragma("unroll") for (int n = 0; n < 2; ++n) _Pragma("unroll") for (int k = 0; k < 2; ++k) dst[n][k] = *(const PG8_LAS bf16x8*)(lds + PG8_SB(b, h) + boff + n * 2048 + k * 1024); } while (0)
#define PG8_MMA(ai, bj, At, Bt) do { __builtin_amdgcn_s_setprio(1); _Pragma("unroll") for (int m = 0; m < 4; ++m) _Pragma("unroll") for (int n = 0; n < 2; ++n) _Pragma("unroll") for (int k = 0; k < 2; ++k) \
        acc[ai][bj][m][n] = __builtin_amdgcn_mfma_f32_16x16x32_bf16(Bt[n][k], At[m][k], acc[ai][bj][m][n], 0, 0, 0); __builtin_amdgcn_s_setprio(0); } while (0)
#define PG8_WAIT_V(n) asm volatile("s_waitcnt vmcnt(" #n ")" ::: "memory")
#define PG8_WAIT_L(n) asm volatile("s_waitcnt lgkmcnt(" #n ")" ::: "memory")
#define PG8_BAR __builtin_amdgcn_s_barrier()
#define PG8_SCHED __builtin_amdgcn_sched_barrier(0)
    Unit cur, nxt; int ui = 0;
    if (!S.next(0, cur)) return;
    f32x4 acc[2][2][4][2];
#pragma unroll
    for (int a = 0; a < 2; ++a)
#pragma unroll
        for (int b = 0; b < 2; ++b)
#pragma unroll
            for (int m = 0; m < 4; ++m)
#pragma unroll
                for (int n = 0; n < 2; ++n) acc[a][b][m][n] = (f32x4){0.f, 0.f, 0.f, 0.f};
    bf16x8 At[4][2], B0[2][2], B1[2][2];
    const char* cA = cur.a; const char* cB = cur.b;
    PG8_STAGE(PG8_SB(0, 0), cB, voffB); PG8_STAGE(PG8_SB(0, 1), cB + hstep, voffB); PG8_STAGE(PG8_SA(0, 0), cA, voffA); PG8_STAGE(PG8_SA(0, 1), cA + hstep, voffA);
    if (wr == 1) PG8_BAR;
    PG8_WAIT_V(2); PG8_BAR;
    PG8_STAGE(PG8_SB(1, 0), cB + kstep, voffB); PG8_STAGE(PG8_SA(1, 0), cA + kstep, voffA); PG8_STAGE(PG8_SB(1, 1), cB + hstep + kstep, voffB);
    PG8_WAIT_V(6); PG8_BAR;
    for (;;) {
        const bool has_next = S.next(ui + 1, nxt);
        const char* nA = has_next ? nxt.a : cA; const char* nB = has_next ? nxt.b : cB;
        for (int t = 0; t < nt; t += 2) {
            const bool last = (t == nt - 2);
            const char* a1 = cA + (size_t)(t + 1) * kstep;
            const char* a2 = last ? nA : cA + (size_t)(t + 2) * kstep; const char* b2 = last ? nB : cB + (size_t)(t + 2) * kstep;
            const char* a3 = a2 + kstep; const char* b3 = b2 + kstep;
            PG8_LDB(B0, 0, 0); PG8_LDB(B1, 0, 1); PG8_SCHED; PG8_LDA(At, 0, 0); PG8_STAGE(PG8_SA(1, 1), a1 + hstep, voffA);
            PG8_WAIT_V(8); PG8_WAIT_L(0); PG8_BAR; PG8_MMA(0, 0, At, B0); PG8_MMA(0, 1, At, B1); PG8_BAR; PG8_SCHED;
            PG8_LDA(At, 0, 1); PG8_STAGE(PG8_SB(0, 0), b2, voffB); PG8_STAGE(PG8_SB(0, 1), b2 + hstep, voffB); PG8_STAGE(PG8_SA(0, 0), a2, voffA);
            PG8_WAIT_V(8); PG8_WAIT_L(0); PG8_BAR; PG8_MMA(1, 0, At, B0); PG8_MMA(1, 1, At, B1); PG8_BAR; PG8_SCHED;
            PG8_LDB(B0, 1, 0); PG8_LDB(B1, 1, 1); PG8_SCHED; PG8_LDA(At, 1, 0); PG8_STAGE(PG8_SA(0, 1), a2 + hstep, voffA);
            PG8_WAIT_V(8); PG8_WAIT_L(0); PG8_BAR; PG8_MMA(0, 0, At, B0); PG8_MMA(0, 1, At, B1); PG8_BAR; PG8_SCHED;
            PG8_LDA(At, 1, 1); PG8_STAGE(PG8_SB(1, 0), b3, voffB); PG8_STAGE(PG8_SB(1, 1), b3 + hstep, voffB); PG8_STAGE(PG8_SA(1, 0), a3, voffA);
            PG8_WAIT_V(8); PG8_WAIT_L(0); PG8_BAR; PG8_MMA(1, 0, At, B0); PG8_MMA(1, 1, At, B1); PG8_BAR; PG8_SCHED;
        }
        if (wr == 0) PG8_BAR;
        E(acc, cur, wr, wc, fr, fq);
        if (!has_next) break;
        if (!E.keep(cur)) {
#pragma unroll
        for (int a = 0; a < 2; ++a)
#pragma unroll
            for (int b = 0; b < 2; ++b)
#pragma unroll
                for (int m = 0; m < 4; ++m)
#pragma unroll
                    for (int n = 0; n < 2; ++n) acc[a][b][m][n] = (f32x4){0.f, 0.f, 0.f, 0.f};
        }
        cur = nxt; cA = nA; cB = nB; ++ui;
        if (wr == 1) PG8_BAR;
    }
    PG8_WAIT_V(0);
    PG8_BAR;
#undef PG8_SA
#undef PG8_SB
#undef PG8_STAGE
#undef PG8_LDA
#undef PG8_LDB
#undef PG8_MMA
#undef PG8_WAIT_V
#undef PG8_WAIT_L
#undef PG8_BAR
#undef PG8_SCHED
}
}

#define XB_TMO      128
#define XB_XCNT(j)  (256  + 64 * (j))
#define XB_XSUB(j)  (1280 + 64 * (j))
#define XB_XGEN(j)  (2304 + 64 * (j))
#define XB_TOP      3328
#define XB_TOPGEN   3392
#define XCD_BAR_WORDS 3456
#define XB_SPIN_CAP (1u << 18)
__device__ __forceinline__ unsigned xb_ld(unsigned* p)              { return __hip_atomic_load(p, __ATOMIC_RELAXED, __HIP_MEMORY_SCOPE_AGENT); }
__device__ __forceinline__ unsigned xb_add(unsigned* p, unsigned v) { return __hip_atomic_fetch_add(p, v, __ATOMIC_RELAXED, __HIP_MEMORY_SCOPE_AGENT); }
__device__ __forceinline__ unsigned xb_xcc_id() { return (unsigned)__builtin_amdgcn_s_getreg((3 << 11) | 20) & 0xFu; }
#define XB_SPIN(cond, bar) do { unsigned _sp = 0; while (cond) { __builtin_amdgcn_s_sleep(1); \
    if ((++_sp & 255u) == 0u) { if (xb_ld(&(bar)[XB_TMO])) break; if (_sp > XB_SPIN_CAP) { atomicAdd(&(bar)[XB_TMO], 1u); break; } } } } while (0)
struct XcdBarrier { unsigned* bar; unsigned x; volatile LAS unsigned* st; };
__device__ __forceinline__ XcdBarrier xcd_barrier_post(unsigned* bar, volatile LAS unsigned* st) {
    XcdBarrier b; b.bar = bar; b.x = xb_xcc_id(); b.st = st;
    if (threadIdx.x == 0) (void)xb_add(&bar[XB_XCNT(b.x)], 1u);
    return b;
}
__device__ __forceinline__ void xcd_barrier_complete(unsigned* bar, unsigned x, unsigned& nloc, unsigned& nx) {
    const unsigned G = gridDim.x * gridDim.y * gridDim.z;
    unsigned sum, cnt, mine, sp = 0u;
    for (;;) {
        sum = 0u; cnt = 0u; mine = 0u;
#pragma unroll
        for (unsigned j = 0; j < 16; ++j) { const unsigned c = xb_ld(&bar[XB_XCNT(j)]); sum += c; cnt += (c > 0u) ? 1u : 0u; mine = (j == x) ? c : mine; }
        if (sum == G) break;
        __builtin_amdgcn_s_sleep(1);
        if ((++sp & 255u) == 0u) { if (xb_ld(&bar[XB_TMO])) break; if (sp > XB_SPIN_CAP) { atomicAdd(&bar[XB_TMO], 1u); break; } }
    }
    nloc = mine > 0u ? mine : 1u; nx = cnt > 0u ? cnt : 1u;
}
__device__ __forceinline__ void xcd_barrier(const XcdBarrier& b) {
    asm volatile("s_waitcnt vmcnt(0)" ::: "memory");
    __syncthreads();
    if (threadIdx.x == 0) {
        unsigned* bar = b.bar;
        __builtin_amdgcn_s_waitcnt(0);
        unsigned nloc = b.st[0], nx = b.st[1];
        if (nloc == 0u) { xcd_barrier_complete(bar, b.x, nloc, nx); b.st[0] = nloc; b.st[1] = nx; }
        const unsigned old = xb_add(&bar[XB_XSUB(b.x)], 1u);
        const unsigned gen = old / nloc;
        if (old + 1u == (gen + 1u) * nloc) {
            __builtin_amdgcn_fence(__ATOMIC_RELEASE, "agent");
            asm volatile("s_waitcnt vmcnt(0)" ::: "memory");
            const unsigned og = xb_add(&bar[XB_TOP], 1u);
            const unsigned tg = og / nx;
            if (og + 1u == (tg + 1u) * nx) xb_add(&bar[XB_TOPGEN], 1u);
            else XB_SPIN(xb_ld(&bar[XB_TOPGEN]) == tg, bar);
            __builtin_amdgcn_fence(__ATOMIC_ACQUIRE, "agent");
            xb_add(&bar[XB_XGEN(b.x)], 1u);
            asm volatile("s_waitcnt vmcnt(0)" ::: "memory");
        } else {
            XB_SPIN(xb_ld(&bar[XB_XGEN(b.x)]) == gen, bar);
            __builtin_amdgcn_fence(__ATOMIC_ACQUIRE, "agent");
            asm volatile("s_waitcnt vmcnt(0)" ::: "memory");
        }
    }
    __syncthreads();
}

struct Args { const float* in[21]; float* out; unsigned char* ws; int ph_lo, ph_hi; };
struct Frame {
    LAS unsigned char* lds;
    int tid, lane, wave, vcu, G;
    const float* in[21]; float* out; unsigned char* ws;
};
__device__ __forceinline__ float wave_sum(float v) {
#pragma unroll
    for (int o = 1; o < 64; o <<= 1) v += __shfl_xor(v, o);
    return v;
}
__device__ __forceinline__ float wave_max(float v) {
#pragma unroll
    for (int o = 1; o < 64; o <<= 1) v = fmaxf(v, __shfl_xor(v, o));
    return v;
}

__device__ __forceinline__ void p0_transpose_item(const float* W, int ldw, int K, bf16* WT, int k0, int n0, int sc0, const float* kscale, LAS float* scr, int lane) {
#pragma unroll 8
    for (int i = 0; i < 32; ++i) { const int kk = 2 * i + (lane >> 5); float w = W[(size_t)(k0 + kk) * ldw + sc0 + (lane & 31)]; if (kscale) w *= kscale[k0 + kk]; scr[kk * 33 + (lane & 31)] = w; }
    LDS_WAIT(); asm volatile("" ::: "memory");
    const int c = lane & 7;
#pragma unroll
    for (int j = 0; j < 4; ++j) { const int n = (lane >> 3) + 8 * j; const LAS float* s = scr + (8 * c) * 33 + n;
        v4u o; o.x = pk2(s[0 * 33], s[1 * 33]); o.y = pk2(s[2 * 33], s[3 * 33]); o.z = pk2(s[4 * 33], s[5 * 33]); o.w = pk2(s[6 * 33], s[7 * 33]);
        *(GAS v4u*)(WT + (size_t)(n0 + n) * K + k0 + 8 * c) = o; }
    LDS_WAIT(); asm volatile("" ::: "memory");
}
__device__ __forceinline__ void rms_row_to_bf16(int lane, const float* xrow, const float* g, bf16* orow) {
    const GAS f32x4* xr = (const GAS f32x4*)xrow + lane;
    f32x4 v[4]; float s2 = 0.f;
#pragma unroll
    for (int j = 0; j < 4; ++j) { v[j] = xr[64 * j]; s2 += (v[j].x * v[j].x + v[j].y * v[j].y) + (v[j].z * v[j].z + v[j].w * v[j].w); }
    const float rstd = 1.f / sqrtf(wave_sum(s2) * (1.f / DM) + EPS);
    GAS unsigned long long* o8 = (GAS unsigned long long*)orow + lane;
#pragma unroll
    for (int j = 0; j < 4; ++j) { const f32x4 gg = ((const GAS f32x4*)g)[lane + 64 * j];
        o8[64 * j] = (unsigned long long)pk2(v[j].x * rstd * gg.x, v[j].y * rstd * gg.y) | ((unsigned long long)pk2(v[j].z * rstd * gg.z, v[j].w * rstd * gg.w) << 32); }
}
__device__ __forceinline__ void p0_prologue(Frame& F) {
    LAS float* scr = (LAS float*)(F.lds + F.wave * 16384);
    const int gw = F.vcu * NWAVES + F.wave, NGW = F.G * NWAVES;
    constexpr int I_IN = 16 * 176, I_A = 8 * 32, I_O = 16 * 32, I_GU = 16 * 176, I_D = 44 * 32;
    constexpr int NITEMS = I_IN + 2 * I_A + I_O + I_GU + I_D;
    for (int it = gw; it < NITEMS; it += NGW) {
        int r = it;
        if (r < I_IN) { const int kb = r / 176, nb = r % 176; p0_transpose_item(F.in[7], DIN, 1024, (bf16*)(F.ws + WS_WIN), 64 * kb, 32 * nb, 32 * nb, nullptr, scr, F.lane); continue; } r -= I_IN;
        if (r < I_A) { const int kb = r / 32, nb = r % 32; p0_transpose_item(F.in[11], DM, 512, (bf16*)(F.ws + WS_WA), 64 * kb, 32 * nb, 32 * nb, nullptr, scr, F.lane); continue; } r -= I_A;
        if (r < I_A) { const int kb = r / 32, nb = r % 32; p0_transpose_item(F.in[12], DM, 512, (bf16*)(F.ws + WS_WB), 64 * kb, 32 * nb, 32 * nb, nullptr, scr, F.lane); continue; } r -= I_A;
        if (r < I_O) { const int kb = r / 32, nb = r % 32; p0_transpose_item(F.in[13], DM, 1024, (bf16*)(F.ws + WS_WOUT), 64 * kb, 32 * nb, 32 * nb, nullptr, scr, F.lane); continue; } r -= I_O;
        if (r < I_GU) { const int kb = r / 176, nb = r % 176; const int n0 = 32 * nb, pn = n0 >> 8, bj = (n0 >> 7) & 1, jj = n0 & 127;
            p0_transpose_item(bj ? F.in[16] : F.in[15], DFF, 1024, (bf16*)(F.ws + WS_WGU), 64 * kb, n0, 128 * pn + jj, F.in[14], scr, F.lane); continue; } r -= I_GU;
        { const int kb = r / 32, nb = r % 32; p0_transpose_item(F.in[19], DM, DFF, (bf16*)(F.ws + WS_WD), 64 * kb, 32 * nb, 32 * nb, nullptr, scr, F.lane); }
    }
    bf16* H = (bf16*)(F.ws + WS_H);
    for (int m = gw; m < MPAD; m += NGW) {
        if (m < MP) rms_row_to_bf16(F.lane, F.in[0] + (size_t)m * DM, F.in[6], H + (size_t)m * DM);
        else if (m < MV) rms_row_to_bf16(F.lane, F.in[1] + (size_t)(m - MP) * DM, F.in[6], H + (size_t)m * DM);
        else { GAS v4u* o = (GAS v4u*)(H + (size_t)m * DM) + F.lane; o[0] = (v4u){0u, 0u, 0u, 0u}; o[64] = (v4u){0u, 0u, 0u, 0u}; }
    }
}

using pg8::Unit; using pg8::TileOrder;
struct PlainSched {
    TileOrder T; int G, c; const char* A; const char* Bt; size_t tstep;
    __device__ __forceinline__ bool next(int i, Unit& u) const { int pm, pn; if (!T.tile((long)i * G + c, pm, pn)) return false; u.pm = pm; u.pn = pn; u.kind = 0; u.idx = i; u.a = A + (size_t)pm * tstep; u.b = Bt + (size_t)pn * tstep; return true; }
};
struct MergeSched {
    TileOrder T; int G, c; const char* A0; const char* A1; const char* B0; const char* B1; size_t tstep;
    __device__ __forceinline__ bool next(int i, Unit& u) const { int pm, pn; if (!T.tile((long)(i >> 1) * G + c, pm, pn)) return false; u.pm = pm; u.pn = pn; u.kind = i & 1; u.idx = i;
        u.a = ((i & 1) ? A1 : A0) + (size_t)pm * tstep; u.b = ((i & 1) ? B1 : B0) + (size_t)pn * tstep; return true; }
};

#define EPI_ROW(u, ai, m) ((u).pm * 256 + (ai) * 128 + wr * 64 + (m) * 16 + fr)
#define EPI_COLT(bj) ((bj) * 128 + wc * 32 + fq * 8)

struct EpiIn {
    unsigned char* ws; const float* lbl; float* out;
    __device__ __forceinline__ bool keep(const Unit&) const { return false; }
    __device__ __forceinline__ void operator()(f32x4 (&acc)[2][2][4][2], const Unit& u, int wr, int wc, int fr, int fq) const {
        const int pn = u.pn;
        int seg, pn0;
        if (pn < 2) { seg = 0; pn0 = 0; } else if (pn < 4) { seg = 1; pn0 = 2; } else if (pn < 6) { seg = 2; pn0 = 4; } else if (pn < 8) { seg = 3; pn0 = 6; } else if (pn < 10) { seg = 4; pn0 = 8; }
        else if (pn < 12) { seg = 5; pn0 = 10; } else if (pn < 14) { seg = 6; pn0 = 12; } else if (pn < 18) { seg = 7; pn0 = 14; } else { seg = 8; pn0 = 18; }
        const int cseg0 = (pn - pn0) * 256;
        if (seg == 4) {
            float* LF = (float*)(ws + WS_LF);
#pragma unroll
            for (int bj = 0; bj < 2; ++bj) { const int cs = cseg0 + EPI_COLT(bj);
                float lb[8];
#pragma unroll
                for (int j = 0; j < 8; ++j) lb[j] = __builtin_amdgcn_rcpf(1.0f + fast_exp(lbl[512 + cs + j] - lbl[cs + j]));
#pragma unroll
                for (int ai = 0; ai < 2; ++ai)
#pragma unroll
                    for (int m = 0; m < 4; ++m) { const int row = EPI_ROW(u, ai, m); f32x4 o0, o1;
#pragma unroll
                        for (int j = 0; j < 4; ++j) { const float f0 = lb[j] + (1.0f - lb[j]) * fast_sigmoid(acc[ai][bj][m][0][j]); o0[j] = __builtin_amdgcn_logf(f0) * LN2;
                                                       const float f1 = lb[4 + j] + (1.0f - lb[4 + j]) * fast_sigmoid(acc[ai][bj][m][1][j]); o1[j] = __builtin_amdgcn_logf(f1) * LN2; }
                        float* p = LF + (size_t)row * 512 + cs; *(f32x4*)p = o0; *(f32x4*)(p + 4) = o1; } }
            return;
        }
        bf16* dst; int ld, act;
        switch (seg) {
            case 0: dst = (bf16*)(ws + WS_QA); ld = 512; act = 1; break;
            case 1: dst = (bf16*)(ws + WS_KA); ld = 512; act = 0; break;
            case 2: dst = (bf16*)(ws + WS_VA); ld = 512; act = 0; break;
            case 3: dst = (bf16*)(ws + WS_QB); ld = 512; act = 2; break;
            case 5: dst = (bf16*)(ws + WS_VB); ld = 512; act = 0; break;
            case 6: dst = (bf16*)(ws + WS_GB); ld = 512; act = 2; break;
            case 7: dst = (bf16*)(ws + WS_ZA); ld = 1024; act = 3; break;
            default: dst = (bf16*)(ws + WS_ZB); ld = 1024; act = 3; break;
        }
        const bool kvout = (seg == 1 || seg == 2) && (u.pm == 128 || (u.pm & 63) >= 62);
#pragma unroll
        for (int ai = 0; ai < 2; ++ai)
#pragma unroll
            for (int m = 0; m < 4; ++m) { const int row = EPI_ROW(u, ai, m);
#pragma unroll
                for (int bj = 0; bj < 2; ++bj) { const int cs = cseg0 + EPI_COLT(bj);
                    f32x4 v0 = acc[ai][bj][m][0], v1 = acc[ai][bj][m][1];
                    if (act == 1) { v0 = v0 * QSCALE; v1 = v1 * QSCALE; }
                    else if (act >= 2) {
#pragma unroll
                        for (int j = 0; j < 4; ++j) { const float s0 = fast_sigmoid(v0[j]), s1 = fast_sigmoid(v1[j]); v0[j] = (act == 2) ? v0[j] * s0 : s0; v1[j] = (act == 2) ? v1[j] * s1 : s1; } }
                    v4u w; w.x = pk2(v0[0], v0[1]); w.y = pk2(v0[2], v0[3]); w.z = pk2(v1[0], v1[1]); w.w = pk2(v1[2], v1[3]);
                    *(v4u*)(dst + (size_t)row * ld + cs) = w;
                    if (kvout) {
                        const int hh = cs >> 6, d = cs & 63; float* o = nullptr;
                        if (row < MP) { const int b = row >> 14, t = row & 16383; if (t >= SEQ - 512) o = out + (seg == 1 ? O_KP : O_VP) + ((size_t)(b * 8 + hh) * 512 + (t - (SEQ - 512))) * 64 + d; }
                        else if (row < MV) { const int bs = (row - MP) >> 4, ts = (row - MP) & 15; o = out + (seg == 1 ? O_KS : O_VS) + ((size_t)(bs * 8 + hh) * 16 + ts) * 64 + d; }
                        if (o) { *(f32x4*)o = v0; *(f32x4*)(o + 4) = v1; }
                    } } }
    }
};

struct EpiMerge {
    const bf16* ZA; const bf16* ZB; bf16* MG;
    __device__ __forceinline__ bool keep(const Unit& u) const { return u.kind == 0; }
    __device__ __forceinline__ void operator()(f32x4 (&acc)[2][2][4][2], const Unit& u, int wr, int wc, int fr, int fq) const {
#pragma unroll
        for (int ai = 0; ai < 2; ++ai)
#pragma unroll
            for (int m = 0; m < 4; ++m) { const int row = EPI_ROW(u, ai, m);
#pragma unroll
                for (int bj = 0; bj < 2; ++bj) { const size_t off = (size_t)row * 1024 + u.pn * 256 + EPI_COLT(bj);
                    const v4u zb = *(const v4u*)(ZB + off);
                    float gb[8] = {bflo(zb.x), bfhi(zb.x), bflo(zb.y), bfhi(zb.y), bflo(zb.z), bfhi(zb.z), bflo(zb.w), bfhi(zb.w)};
                    if (u.kind == 0) {
                        const v4u za = *(const v4u*)(ZA + off);
                        float ga[8] = {bflo(za.x), bfhi(za.x), bflo(za.y), bfhi(za.y), bflo(za.z), bfhi(za.z), bflo(za.w), bfhi(za.w)};
#pragma unroll
                        for (int j = 0; j < 4; ++j) { acc[ai][bj][m][0][j] *= ga[j] * __builtin_amdgcn_rcpf(gb[j]); acc[ai][bj][m][1][j] *= ga[4 + j] * __builtin_amdgcn_rcpf(gb[4 + j]); }
                    } else {
                        f32x4 v0 = acc[ai][bj][m][0], v1 = acc[ai][bj][m][1];
#pragma unroll
                        for (int j = 0; j < 4; ++j) { v0[j] *= gb[j]; v1[j] *= gb[4 + j]; }
                        v4u w; w.x = pk2(v0[0], v0[1]); w.y = pk2(v0[2], v0[3]); w.z = pk2(v1[0], v1[1]); w.w = pk2(v1[2], v1[3]);
                        *(v4u*)(MG + off) = w;
                    } } }
    }
};

template <bool DOWN> struct EpiRes {
    const float* xp; const float* xs; float* out; bf16* X1B; float* RS;
    __device__ __forceinline__ bool keep(const Unit&) const { return false; }
    __device__ __forceinline__ void operator()(f32x4 (&acc)[2][2][4][2], const Unit& u, int wr, int wc, int fr, int fq) const {
#pragma unroll
        for (int ai = 0; ai < 2; ++ai)
#pragma unroll
            for (int m = 0; m < 4; ++m) { const int row = EPI_ROW(u, ai, m); float ss = 0.f;
                const bool valid = row < MV;
#pragma unroll
                for (int bj = 0; bj < 2; ++bj) { const int col = u.pn * 256 + EPI_COLT(bj);
                    f32x4 v0 = acc[ai][bj][m][0], v1 = acc[ai][bj][m][1];
                    if (valid) {
                        const float* src = DOWN ? out + (size_t)row * DM + col : (row < MP ? xp + (size_t)row * DM + col : xs + (size_t)(row - MP) * DM + col);
                        v0 = v0 + *(const f32x4*)src; v1 = v1 + *(const f32x4*)(src + 4);
                        float* o = out + (size_t)row * DM + col; *(f32x4*)o = v0; *(f32x4*)(o + 4) = v1;
                    }
                    if (!DOWN) { v4u w; w.x = pk2(v0[0], v0[1]); w.y = pk2(v0[2], v0[3]); w.z = pk2(v1[0], v1[1]); w.w = pk2(v1[2], v1[3]); *(v4u*)(X1B + (size_t)row * DM + col) = w; }
                    ss += (v0[0] * v0[0] + v0[1] * v0[1]) + (v0[2] * v0[2] + v0[3] * v0[3]) + (v1[0] * v1[0] + v1[1] * v1[1]) + (v1[2] * v1[2] + v1[3] * v1[3]); }
                ss += __shfl_xor(ss, 16); ss += __shfl_xor(ss, 32);
                if (fq == 0) RS[(size_t)row * 16 + u.pn * 4 + wc] = ss; }
    }
};
__device__ __forceinline__ float row_rstd(const float* RS, int row) {
    const f32x4* p = (const f32x4*)(RS + (size_t)row * 16);
    const f32x4 a = p[0], b = p[1], c = p[2], d = p[3];
    const float s = ((a[0] + a[1]) + (a[2] + a[3])) + ((b[0] + b[1]) + (b[2] + b[3])) + ((c[0] + c[1]) + (c[2] + c[3])) + ((d[0] + d[1]) + (d[2] + d[3]));
    return 1.0f / sqrtf(s * (1.0f / DM) + EPS);
}

__device__ __forceinline__ float gelu_tanh(float x) { const float z = 1.5957691216057308f * (x + 0.044715f * x * x * x); return x * __builtin_amdgcn_rcpf(1.0f + __builtin_amdgcn_exp2f(-z * LOG2E)); }
struct EpiGU {
    const LAS float* rstdL; bf16* G; float* ST; const float* cw; const float* cb; float* out;
    __device__ __forceinline__ bool keep(const Unit&) const { return false; }
    __device__ __forceinline__ void operator()(f32x4 (&acc)[2][2][4][2], const Unit& u, int wr, int wc, int fr, int fq) const {
        const int n0 = u.pn * 128 + wc * 32 + fq * 8;
        const int lane = fq * 16 + fr, src1 = (lane & 48) | ((fr - 1) & 15), src2 = (lane & 48) | ((fr - 2) & 15);
#pragma unroll
        for (int hf = 0; hf < 2; ++hf) {
            const int nc = n0 + 4 * hf;
            const f32x4 cbv = *(const f32x4*)(cb + nc), c0 = *(const f32x4*)(cw + nc), c1 = *(const f32x4*)(cw + DFF + nc), c2 = *(const f32x4*)(cw + 2 * DFF + nc);
#pragma unroll
            for (int ai = 0; ai < 2; ++ai) {
                f32x4 ap = {0.f, 0.f, 0.f, 0.f};
#pragma unroll
                for (int m = 0; m < 4; ++m) { const int row = EPI_ROW(u, ai, m); const float rs = rstdL[u.idx * 256 + ai * 128 + wr * 64 + m * 16 + fr];
                    const f32x4 a = acc[ai][0][m][hf] * rs, uu = acc[ai][1][m][hf] * rs; f32x4 g;
#pragma unroll
                    for (int j = 0; j < 4; ++j) {
                        const float t1 = __shfl(a[j], src1), t2 = __shfl(a[j], src2), q1 = __shfl(ap[j], src1), q2 = __shfl(ap[j], src2);
                        const float p1 = fr >= 1 ? t1 : q1, p2 = fr >= 2 ? t2 : q2;
                        g[j] = gelu_tanh(cbv[j] + c0[j] * p2 + c1[j] * p1 + c2[j] * a[j]) * uu[j];
                    }
                    const int sp = row >> 6;
                    if (m == 0 && fr < 2) { *(f32x4*)(ST + ((size_t)sp * 6 + fr) * DFF + nc) = a; *(f32x4*)(ST + ((size_t)sp * 6 + 2 + fr) * DFF + nc) = uu; }
                    else { *(unsigned long long*)(G + (size_t)row * DFF + nc) = (unsigned long long)pk2(g[0], g[1]) | ((unsigned long long)pk2(g[2], g[3]) << 32); }
                    if (m == 3 && fr >= 14) {
                        *(f32x4*)(ST + ((size_t)sp * 6 + 4 + (fr - 14)) * DFF + nc) = a;
                        if ((row & 16383) >= SEQ - 2) *(f32x4*)(out + O_CP + ((size_t)(row >> 14) * 2 + ((row & 16383) - (SEQ - 2))) * DFF + nc) = a;
                    }
                    ap = a;
                }
            }
        }
    }
};

__device__ __forceinline__ float dot8(const v4u q, const v4u k) {
    return (bflo(q.x) * bflo(k.x) + bfhi(q.x) * bfhi(k.x)) + (bflo(q.y) * bflo(k.y) + bfhi(q.y) * bfhi(k.y)) + (bflo(q.z) * bflo(k.z) + bfhi(q.z) * bfhi(k.z)) + (bflo(q.w) * bflo(k.w) + bfhi(q.w) * bfhi(k.w));
}
__device__ __forceinline__ float dot8f(const v4u q, const f32x4 k0, const f32x4 k1) {
    return (bflo(q.x) * k0[0] + bfhi(q.x) * k0[1]) + (bflo(q.y) * k0[2] + bfhi(q.y) * k0[3]) + (bflo(q.z) * k1[0] + bfhi(q.z) * k1[1]) + (bflo(q.w) * k1[2] + bfhi(q.w) * k1[3]);
}
template <bool SAMPLE>
__device__ __forceinline__ void attn_simple_row(Frame& F, int qrow, int h) {
    const bf16* QA = (const bf16*)(F.ws + WS_QA); const bf16* KA = (const bf16*)(F.ws + WS_KA); const bf16* VA = (const bf16*)(F.ws + WS_VA);
    bf16* OA = (bf16*)((unsigned char*)F.out + DO_OA);
    const float* bias = F.in[8] + h * NREL;
    const int lane = F.lane;
    v4u q8[8];
#pragma unroll
    for (int i = 0; i < 8; ++i) q8[i] = *(const v4u*)(QA + (size_t)qrow * 512 + 64 * h + 8 * i);
    int b, qpos, kbase, nk;
    if (!SAMPLE) { b = qrow >> 14; qpos = qrow & 16383; kbase = 64 * ((qpos >> 6) - 8); nk = 576; }
    else { b = (qrow - MP) >> 4; qpos = PAST + ((qrow - MP) & 15); kbase = PAST - 512; nk = 528; }
    LAS float* wsc = (LAS float*)(F.lds + 32768 + F.wave * 4096);
    float mx = -INFINITY;
#pragma unroll 1
    for (int r = 0; r < 9; ++r) {
        const int j = 64 * r + lane; float sc = -INFINITY;
        if (j < nk) {
            const int kpos = kbase + j;
            if (!SAMPLE) {
                if (kpos >= 0) { const bf16* kp = KA + ((size_t)b * SEQ + kpos) * 512 + 64 * h; float d = 0.f;
#pragma unroll
                    for (int i = 0; i < 8; ++i) d += dot8(q8[i], *(const v4u*)(kp + 8 * i));
                    int dd = qpos - kpos; dd = dd < -63 ? -63 : (dd > 128 ? 128 : dd); sc = d + bias[dd + 63] * LOG2E; }
            } else {
                float d = 0.f;
                if (j < 512) { const float* kp = F.in[2] + ((size_t)(b * 8 + h) * 512 + j) * 64;
#pragma unroll
                    for (int i = 0; i < 8; ++i) d += dot8f(q8[i], *(const f32x4*)(kp + 8 * i), *(const f32x4*)(kp + 8 * i + 4)); }
                else { const bf16* kp = KA + ((size_t)MP + b * 16 + (j - 512)) * 512 + 64 * h;
#pragma unroll
                    for (int i = 0; i < 8; ++i) d += dot8(q8[i], *(const v4u*)(kp + 8 * i)); }
                int dd = qpos - kpos; dd = dd < -63 ? -63 : (dd > 128 ? 128 : dd); sc = d + bias[dd + 63] * LOG2E;
            }
        }
        wsc[j] = sc; mx = fmaxf(mx, sc);
    }
    mx = wave_max(mx); float l = 0.f;
#pragma unroll 1
    for (int r = 0; r < 9; ++r) { const float p = __builtin_amdgcn_exp2f(wsc[64 * r + lane] - mx); wsc[64 * r + lane] = p; l += p; }
    l = wave_sum(l);
    LDS_WAIT();
    float o = 0.f;
    const int jlo = (!SAMPLE && kbase < 0) ? -kbase : 0;
#pragma unroll 4
    for (int j = jlo; j < nk; ++j) {
        const float p = wsc[j];
        float vv;
        if (!SAMPLE) vv = bf2f(VA[((size_t)b * SEQ + kbase + j) * 512 + 64 * h + lane]);
        else if (j < 512) vv = F.in[3][((size_t)(b * 8 + h) * 512 + j) * 64 + lane];
        else vv = bf2f(VA[((size_t)MP + b * 16 + (j - 512)) * 512 + 64 * h + lane]);
        o += p * vv;
    }
    o *= __builtin_amdgcn_rcpf(l);
    const unsigned ob = pk2(o, 0.f) & 0xffffu;
    OA[(size_t)qrow * 512 + 64 * h + lane] = (bf16)ob;
}


constexpr int AT_K0 = 0, AT_V0 = 9216, AT_BUF = 18432, AT_BIAS = 36864, AT_WS = 37888;
__device__ __forceinline__ void attn_unit(Frame& F, int unit) {
    const int bh = unit >> 6, qg = unit & 63, b = bh >> 3, h = bh & 7;
    const int tid = F.tid, lane = F.lane, wave = F.wave, hi = lane >> 5, l31 = lane & 31;
    const int ci = wave >> 1, cq = 4 * qg + ci, iq = 32 * (wave & 1) + l31;
    LAS unsigned char* L = F.lds;
    LAS float* biasL = (LAS float*)(L + AT_BIAS); LAS float* wsf = (LAS float*)(L + AT_WS) + wave * 64;
    if (tid < NREL) biasL[tid] = F.in[8][h * NREL + tid] * LOG2E;
    const bf16* QA = (const bf16*)(F.ws + WS_QA); const bf16* KA = (const bf16*)(F.ws + WS_KA); const bf16* VA = (const bf16*)(F.ws + WS_VA);
    bf16* OA = (bf16*)((unsigned char*)F.out + DO_OA);
    const size_t qrow = (size_t)b * SEQ + cq * 64 + iq;
    bf16x8 qr[4];
#pragma unroll
    for (int d0 = 0; d0 < 4; ++d0) qr[d0] = *(const bf16x8*)(QA + qrow * 512 + 64 * h + 16 * d0 + 8 * hi);
    const int j0 = (8 - 4 * qg) > 0 ? (8 - 4 * qg) : 0;
    const int vpos = (lane & ~15) | (8 * ((lane >> 2) & 1) + 4 * ((lane >> 3) & 1) + (lane & 3));
    v4u kreg, vreg;
#define AT_LOADG(j) do { const size_t rb = (size_t)b * SEQ + (size_t)(4 * qg - 8 + (j)) * 64; \
        kreg = *(const v4u*)(KA + (rb + (tid >> 3)) * 512 + 64 * h + 8 * (tid & 7)); vreg = *(const v4u*)(VA + (rb + lane) * 512 + 64 * h + 8 * wave); } while (0)
#define AT_STORE(buf) do { LAS unsigned char* B_ = L + (buf) * AT_BUF; *(LAS v4u*)(B_ + AT_K0 + (tid >> 3) * 144 + (tid & 7) * 16) = kreg; \
        LAS unsigned char* V_ = B_ + AT_V0 + (8 * wave) * 144 + 2 * vpos; \
        *(LAS unsigned short*)(V_ + 0 * 144) = (unsigned short)(vreg.x & 0xffffu); *(LAS unsigned short*)(V_ + 1 * 144) = (unsigned short)(vreg.x >> 16); \
        *(LAS unsigned short*)(V_ + 2 * 144) = (unsigned short)(vreg.y & 0xffffu); *(LAS unsigned short*)(V_ + 3 * 144) = (unsigned short)(vreg.y >> 16); \
        *(LAS unsigned short*)(V_ + 4 * 144) = (unsigned short)(vreg.z & 0xffffu); *(LAS unsigned short*)(V_ + 5 * 144) = (unsigned short)(vreg.z >> 16); \
        *(LAS unsigned short*)(V_ + 6 * 144) = (unsigned short)(vreg.w & 0xffffu); *(LAS unsigned short*)(V_ + 7 * 144) = (unsigned short)(vreg.w >> 16); } while (0)
    AT_LOADG(j0); AT_STORE(0);
    __syncthreads();
    float m_run = -INFINITY, l_run = 0.f; f32x16 o0 = {}, o1 = {};
    for (int j = j0; j < 12; ++j) {
        const int cur = (j - j0) & 1;
        if (j + 1 < 12) AT_LOADG(j + 1);
        if (j >= ci && j <= ci + 8) {
            const LAS unsigned char* Kb = L + cur * AT_BUF + AT_K0; const LAS unsigned char* Vb = L + cur * AT_BUF + AT_V0;
            const int dc = ci + 8 - j;
            f32x16 s0 = {}, s1 = {};
#pragma unroll
            for (int d0 = 0; d0 < 4; ++d0) {
                const bf16x8 k0 = *(const LAS bf16x8*)(Kb + l31 * 144 + (16 * d0 + 8 * hi) * 2);
                const bf16x8 k1 = *(const LAS bf16x8*)(Kb + (32 + l31) * 144 + (16 * d0 + 8 * hi) * 2);
                s0 = __builtin_amdgcn_mfma_f32_32x32x16_bf16(k0, qr[d0], s0, 0, 0, 0); s1 = __builtin_amdgcn_mfma_f32_32x32x16_bf16(k1, qr[d0], s1, 0, 0, 0);
            }
            if (dc >= 3) { const float bc = biasL[NREL - 1];
#pragma unroll
                for (int r = 0; r < 16; ++r) { s0[r] += bc; s1[r] += bc; } }
            else {
#pragma unroll
                for (int r = 0; r < 16; ++r) { int d = 64 * dc + iq - crow(r, hi); int d1 = d - 32;
                    d = d < -63 ? -63 : (d > 128 ? 128 : d); d1 = d1 < -63 ? -63 : (d1 > 128 ? 128 : d1);
                    s0[r] += biasL[d + 63]; s1[r] += biasL[d1 + 63]; } }
            float mx = fmaxf(s0[0], s1[0]);
#pragma unroll
            for (int r = 1; r < 16; ++r) mx = fmaxf(mx, fmaxf(s0[r], s1[r]));
            mx = fmaxf(mx, __shfl_xor(mx, 32));
            const float m_new = fmaxf(m_run, mx), alpha = __builtin_amdgcn_exp2f(m_run - m_new); m_run = m_new;
            float ps = 0.f;
#pragma unroll
            for (int r = 0; r < 16; ++r) { s0[r] = __builtin_amdgcn_exp2f(s0[r] - m_new); s1[r] = __builtin_amdgcn_exp2f(s1[r] - m_new); ps += s0[r] + s1[r]; }
            l_run = l_run * alpha + ps;
            if (hi == 0) wsf[l31] = alpha;
#pragma unroll
            for (int g = 0; g < 4; ++g) { const f32x4 a4 = *(const LAS f32x4*)(wsf + 8 * g + 4 * hi);
#pragma unroll
                for (int jj = 0; jj < 4; ++jj) { o0[4 * g + jj] *= a4[jj]; o1[4 * g + jj] *= a4[jj]; } }
#pragma unroll
            for (int s2 = 0; s2 < 2; ++s2) {
                v4u pw; pw.x = pk2(s0[8 * s2 + 0], s0[8 * s2 + 1]); pw.y = pk2(s0[8 * s2 + 2], s0[8 * s2 + 3]); pw.z = pk2(s0[8 * s2 + 4], s0[8 * s2 + 5]); pw.w = pk2(s0[8 * s2 + 6], s0[8 * s2 + 7]);
                const bf16x8 pa = __builtin_bit_cast(bf16x8, pw);
                const bf16x8 v0 = *(const LAS bf16x8*)(Vb + l31 * 144 + (16 * s2 + 8 * hi) * 2);
                const bf16x8 v1 = *(const LAS bf16x8*)(Vb + (32 + l31) * 144 + (16 * s2 + 8 * hi) * 2);
                o0 = __builtin_amdgcn_mfma_f32_32x32x16_bf16(pa, v0, o0, 0, 0, 0); o1 = __builtin_amdgcn_mfma_f32_32x32x16_bf16(pa, v1, o1, 0, 0, 0);
            }
#pragma unroll
            for (int s2 = 0; s2 < 2; ++s2) {
                v4u pw; pw.x = pk2(s1[8 * s2 + 0], s1[8 * s2 + 1]); pw.y = pk2(s1[8 * s2 + 2], s1[8 * s2 + 3]); pw.z = pk2(s1[8 * s2 + 4], s1[8 * s2 + 5]); pw.w = pk2(s1[8 * s2 + 6], s1[8 * s2 + 7]);
                const bf16x8 pa = __builtin_bit_cast(bf16x8, pw);
                const bf16x8 v0 = *(const LAS bf16x8*)(Vb + l31 * 144 + (32 + 16 * s2 + 8 * hi) * 2);
                const bf16x8 v1 = *(const LAS bf16x8*)(Vb + (32 + l31) * 144 + (32 + 16 * s2 + 8 * hi) * 2);
                o0 = __builtin_amdgcn_mfma_f32_32x32x16_bf16(pa, v0, o0, 0, 0, 0); o1 = __builtin_amdgcn_mfma_f32_32x32x16_bf16(pa, v1, o1, 0, 0, 0);
            }
        }
        if (j + 1 < 12) AT_STORE(cur ^ 1);
        __syncthreads();
    }
#undef AT_LOADG
#undef AT_STORE
    l_run += __shfl_xor(l_run, 32);
    if (hi == 0) wsf[l31] = __builtin_amdgcn_rcpf(l_run);
    const size_t orow0 = (size_t)b * SEQ + cq * 64 + 32 * (wave & 1);
#pragma unroll
    for (int g = 0; g < 4; ++g) { const f32x4 a4 = *(const LAS f32x4*)(wsf + 8 * g + 4 * hi);
#pragma unroll
        for (int jj = 0; jj < 4; ++jj) { const int r = 4 * g + jj; bf16* op = OA + (orow0 + crow(r, hi)) * 512 + 64 * h + l31; op[0] = bf1(o0[r] * a4[jj]); op[32] = bf1(o1[r] * a4[jj]); } }
    __syncthreads();
}

__device__ __forceinline__ void hgrn_simple(Frame& F, int row0, int L, int h, const float* S0, float* Sout) {
    const float* LF = (const float*)(F.ws + WS_LF); const bf16* QB = (const bf16*)(F.ws + WS_QB); const bf16* VB = (const bf16*)(F.ws + WS_VB); const bf16* GB = (const bf16*)(F.ws + WS_GB);
    bf16* OB = (bf16*)((unsigned char*)F.out + DO_OB);
    const float* gn = F.in[10];
    const int tid = F.tid, v = tid & 127, kg = __builtin_amdgcn_readfirstlane(tid >> 7);
    LAS float* opart = (LAS float*)F.lds;
    float S[32];
#pragma unroll
    for (int i = 0; i < 32; ++i) S[i] = S0 ? S0[(size_t)(32 * kg + i) * 128 + v] : 0.f;
    for (int t0 = 0; t0 < L; t0 += 16) {
        for (int tt = 0; tt < 16; ++tt) {
            const size_t row = (size_t)row0 + t0 + tt;
            const float* lf = LF + row * 512 + 128 * h + 32 * kg;
            const bf16* qp = QB + row * 512 + 128 * h + 32 * kg;
            const float vv = bf2f(VB[row * 512 + 128 * h + v]);
            float acc = 0.f;
#pragma unroll
            for (int i = 0; i < 32; ++i) { const float f = fast_exp(lf[i]); S[i] = f * S[i] + (1.0f - f) * vv; acc += bf2f(qp[i]) * S[i]; }
            opart[(tt * 4 + kg) * 128 + v] = acc;
        }
        __syncthreads();
        {
            const int tt = tid >> 5, v4 = (tid & 31) * 4; const size_t row = (size_t)row0 + t0 + tt;
            float o[4]; float ss = 0.f;
#pragma unroll
            for (int i = 0; i < 4; ++i) { o[i] = (opart[(tt * 4 + 0) * 128 + v4 + i] + opart[(tt * 4 + 1) * 128 + v4 + i]) + (opart[(tt * 4 + 2) * 128 + v4 + i] + opart[(tt * 4 + 3) * 128 + v4 + i]); ss += o[i] * o[i]; }
#pragma unroll
            for (int of = 1; of < 32; of <<= 1) ss += __shfl_xor(ss, of);
            const float rstd = 1.0f / sqrtf(ss * (1.0f / 128.0f) + EPS);
            const bf16* gp = GB + row * 512 + 128 * h + v4;
            float r[4];
#pragma unroll
            for (int i = 0; i < 4; ++i) r[i] = o[i] * rstd * gn[v4 + i] * bf2f(gp[i]);
            unsigned long long w = (unsigned long long)pk2(r[0], r[1]) | ((unsigned long long)pk2(r[2], r[3]) << 32);
            *(unsigned long long*)(OB + row * 512 + 128 * h + v4) = w;
        }
        __syncthreads();
    }
#pragma unroll
    for (int i = 0; i < 32; ++i) Sout[(size_t)(32 * kg + i) * 128 + v] = S[i];
}


constexpr int HA_KT = 0, HA_VT = 18432, HA_TOT = 36864;
__device__ __forceinline__ void hg_prefix(const float* LF, int row0, int h, int k, int tg, LAS float* tot, float (&lf)[16], float (&cs)[16], float& r1, float& r2, float& r3, float& bC) {
#pragma unroll
    for (int i = 0; i < 16; ++i) lf[i] = LF[(size_t)(row0 + 16 * tg + i) * 512 + 128 * h + k];
    float run = 0.f;
#pragma unroll
    for (int i = 0; i < 16; ++i) { run += lf[i]; cs[i] = run; }
    tot[tg * 128 + k] = run;
    __syncthreads();
    r1 = tot[k]; r2 = r1 + tot[128 + k]; r3 = r2 + tot[256 + k]; bC = r3 + tot[384 + k];
}
__device__ __forceinline__ void hg_load_vt(const bf16* VB, int row0, int h, int v, int tg, LAS unsigned char* VT) {
    unsigned short x[16];
#pragma unroll
    for (int i = 0; i < 16; ++i) x[i] = VB[(size_t)(row0 + 16 * tg + i) * 512 + 128 * h + v];
    v4u w0, w1;
    w0.x = x[0] | ((unsigned)x[1] << 16); w0.y = x[2] | ((unsigned)x[3] << 16); w0.z = x[4] | ((unsigned)x[5] << 16); w0.w = x[6] | ((unsigned)x[7] << 16);
    w1.x = x[8] | ((unsigned)x[9] << 16); w1.y = x[10] | ((unsigned)x[11] << 16); w1.z = x[12] | ((unsigned)x[13] << 16); w1.w = x[14] | ((unsigned)x[15] << 16);
    *(LAS v4u*)(VT + v * 144 + tg * 32) = w0; *(LAS v4u*)(VT + v * 144 + tg * 32 + 16) = w1;
}
__device__ __forceinline__ void hgrn_passA_item(Frame& F, int item) {
    const int c = item & 255, bh = item >> 8, b = bh >> 2, h = bh & 3, row0 = b * SEQ + c * 64;
    LAS unsigned char* L = F.lds; LAS float* tot = (LAS float*)(L + HA_TOT);
    const int k = F.tid & 127, tg = F.tid >> 7, lane = F.lane, hi = lane >> 5, l31 = lane & 31;
    float lf[16], cs[16], r1, r2, r3, bC;
    hg_prefix((const float*)(F.ws + WS_LF), row0, h, k, tg, tot, lf, cs, r1, r2, r3, bC);
    const float rown = tg == 0 ? 0.f : (tg == 1 ? r1 : (tg == 2 ? r2 : r3));
    unsigned kw[8];
#pragma unroll
    for (int i = 0; i < 16; i += 2) { const float e0 = (1.0f - fast_exp(lf[i])) * fast_exp(bC - (rown + cs[i])), e1 = (1.0f - fast_exp(lf[i + 1])) * fast_exp(bC - (rown + cs[i + 1])); kw[i >> 1] = pk2(e0, e1); }
    *(LAS v4u*)(L + HA_KT + k * 144 + tg * 32) = (v4u){kw[0], kw[1], kw[2], kw[3]}; *(LAS v4u*)(L + HA_KT + k * 144 + tg * 32 + 16) = (v4u){kw[4], kw[5], kw[6], kw[7]};
    hg_load_vt((const bf16*)(F.ws + WS_VB), row0, h, k, tg, L + HA_VT);
    if (tg == 0) ((float*)(F.ws + WS_DC))[(size_t)item * 128 + k] = fast_exp(bC);
    __syncthreads();
    const int vb = F.wave >> 1, kb0 = (F.wave & 1) * 2;
    f32x16 a0 = {}, a1 = {};
#pragma unroll
    for (int st = 0; st < 4; ++st) {
        const bf16x8 av = *(const LAS bf16x8*)(L + HA_VT + (32 * vb + l31) * 144 + (16 * st + 8 * hi) * 2);
        const bf16x8 b0 = *(const LAS bf16x8*)(L + HA_KT + (32 * kb0 + l31) * 144 + (16 * st + 8 * hi) * 2);
        const bf16x8 b1 = *(const LAS bf16x8*)(L + HA_KT + (32 * (kb0 + 1) + l31) * 144 + (16 * st + 8 * hi) * 2);
        a0 = __builtin_amdgcn_mfma_f32_32x32x16_bf16(av, b0, a0, 0, 0, 0); a1 = __builtin_amdgcn_mfma_f32_32x32x16_bf16(av, b1, a1, 0, 0, 0);
    }
    bf16* U = (bf16*)(F.ws + WS_US) + (size_t)item * 16384;
#pragma unroll
    for (int r = 0; r < 16; ++r) { const int v = 32 * vb + crow(r, hi); U[v * 128 + 32 * kb0 + l31] = bf1(a0[r]); U[v * 128 + 32 * (kb0 + 1) + l31] = bf1(a1[r]); }
    __syncthreads();
}
__device__ __forceinline__ void hgrn_scan(Frame& F) {
    for (int e = blockIdx.x * 512 + F.tid; e < 8 * 16384; e += F.G * 512) {
        const int bh = e >> 14, idx = e & 16383, k = idx & 127, v = idx >> 7;
        bf16* U = (bf16*)(F.ws + WS_US) + (size_t)bh * 256 * 16384 + idx; const float* D = (const float*)(F.ws + WS_DC) + (size_t)bh * 256 * 128 + k;
        float S = 0.f;
        for (int c = 0; c < 256; c += 8) {
            float u[8], d[8];
#pragma unroll
            for (int j = 0; j < 8; ++j) { u[j] = bf2f(U[(size_t)(c + j) * 16384]); d[j] = D[(c + j) * 128]; }
#pragma unroll
            for (int j = 0; j < 8; ++j) { U[(size_t)(c + j) * 16384] = bf1(S); S = d[j] * S + u[j]; }
        }
        F.out[O_HP + (size_t)bh * 16384 + k * 128 + v] = S;
    }
}
constexpr int HC_QE = 0, HC_QS = 17408, HC_KS = 34816, HC_ST = 78336, HC_VT = 113152, HC_AM = 131584, HC_TOT = 140800, HC_END = 142848, HC_OT = 0;
static_assert(HC_END <= LDSCTL_OFF, "pass C LDS map");
__device__ __forceinline__ void hgrn_passC_item(Frame& F, int item) {
    const int c = item & 255, bh = item >> 8, b = bh >> 2, h = bh & 3, row0 = b * SEQ + c * 64;
    LAS unsigned char* L = F.lds; LAS float* tot = (LAS float*)(L + HC_TOT);
    const int tid = F.tid, k = tid & 127, tg = tid >> 7, lane = F.lane, hi = lane >> 5, l31 = lane & 31;
    const bf16* QB = (const bf16*)(F.ws + WS_QB);
    {
        float lf[16], cs[16], r1, r2, r3, bC;
        hg_prefix((const float*)(F.ws + WS_LF), row0, h, k, tg, tot, lf, cs, r1, r2, r3, bC);
        const float rown = tg == 0 ? 0.f : (tg == 1 ? r1 : (tg == 2 ? r2 : r3));
        const float town = cs[15], rnext = rown + town;
        const float erow = fast_exp(rown);
        const float g1 = fast_exp(r1 - rnext), g2 = fast_exp(r2 - rnext), g3 = fast_exp(r3 - rnext);
        const int ksd = tg == 0 ? 0 : (tg == 1 ? 16 : (tg == 2 ? 48 : 96));
#pragma unroll
        for (int i = 0; i < 16; ++i) {
            const int s = 16 * tg + i;
            const float q = bf2f(QB[(size_t)(row0 + s) * 512 + 128 * h + k]);
            const float ec = fast_exp(cs[i]);
            const float qs = q * ec;
            *(LAS unsigned short*)(L + HC_QS + s * 272 + k * 2) = bf1(qs);
            *(LAS unsigned short*)(L + HC_QE + s * 272 + k * 2) = bf1(qs * erow);
            const float kk = 1.0f - fast_exp(lf[i]);
            *(LAS unsigned short*)(L + HC_KS + (ksd + s) * 272 + k * 2) = bf1(kk * fast_exp(fminf(-cs[i], 80.0f)));
            const float E = kk * fast_exp(town - cs[i]);
            if (tg < 1) *(LAS unsigned short*)(L + HC_KS + (16 + s) * 272 + k * 2) = bf1(E * g1);
            if (tg < 2) *(LAS unsigned short*)(L + HC_KS + (48 + s) * 272 + k * 2) = bf1(E * g2);
            if (tg < 3) *(LAS unsigned short*)(L + HC_KS + (96 + s) * 272 + k * 2) = bf1(E * g3);
        }
    }
    hg_load_vt((const bf16*)(F.ws + WS_VB), row0, h, k, tg, L + HC_VT);
    {
        const unsigned char* Sg = F.ws + WS_US + (size_t)item * 32768;
#pragma unroll
        for (int i = 0; i < 4; ++i) { const int idx = tid + 512 * i, row = idx >> 4, ch = idx & 15; *(LAS v4u*)(L + HC_ST + row * 272 + ch * 16) = *(const v4u*)(Sg + row * 256 + ch * 16); }
        for (int idx = tid; idx < 576; idx += 512) *(LAS v4u*)(L + HC_AM + idx * 16) = (v4u){0u, 0u, 0u, 0u};
    }
    __syncthreads();
    {
        const int fr = lane & 15, fq = lane >> 4;
        for (int bidx = F.wave; bidx < 10; bidx += 8) {
            const int i = bidx < 1 ? 0 : (bidx < 3 ? 1 : (bidx < 6 ? 2 : 3)), j = bidx - (i * (i + 1)) / 2;
            const int kso = i == 0 ? 0 : (i == 1 ? 16 : (i == 2 ? 48 : 96));
            f32x4 d = {0.f, 0.f, 0.f, 0.f};
#pragma unroll
            for (int st = 0; st < 4; ++st) {
                const bf16x8 a = *(const LAS bf16x8*)(L + HC_QS + (16 * i + fr) * 272 + (32 * st + 8 * fq) * 2);
                const bf16x8 bb = *(const LAS bf16x8*)(L + HC_KS + (kso + 16 * j + fr) * 272 + (32 * st + 8 * fq) * 2);
                d = __builtin_amdgcn_mfma_f32_16x16x32_bf16(a, bb, d, 0, 0, 0);
            }
#pragma unroll
            for (int r = 0; r < 4; ++r) { const int tt = 4 * fq + r; const float val = (i == j && fr > tt) ? 0.f : d[r];
                *(LAS unsigned short*)(L + HC_AM + (16 * i + tt) * 144 + (16 * j + fr) * 2) = bf1(val); }
        }
    }
    __syncthreads();
    f32x16 o = {};
    {
        const int tb = F.wave >> 2, vb = F.wave & 3;
#pragma unroll
        for (int st = 0; st < 8; ++st) {
            const bf16x8 a = *(const LAS bf16x8*)(L + HC_QE + (32 * tb + l31) * 272 + (16 * st + 8 * hi) * 2);
            const bf16x8 bb = *(const LAS bf16x8*)(L + HC_ST + (32 * vb + l31) * 272 + (16 * st + 8 * hi) * 2);
            o = __builtin_amdgcn_mfma_f32_32x32x16_bf16(a, bb, o, 0, 0, 0);
        }
#pragma unroll
        for (int st = 0; st < 4; ++st) {
            const bf16x8 a = *(const LAS bf16x8*)(L + HC_AM + (32 * tb + l31) * 144 + (16 * st + 8 * hi) * 2);
            const bf16x8 bb = *(const LAS bf16x8*)(L + HC_VT + (32 * vb + l31) * 144 + (16 * st + 8 * hi) * 2);
            o = __builtin_amdgcn_mfma_f32_32x32x16_bf16(a, bb, o, 0, 0, 0);
        }
        __syncthreads();
        LAS float* OT = (LAS float*)(L + HC_OT);
#pragma unroll
        for (int r = 0; r < 16; ++r) OT[(32 * tb + crow(r, hi)) * 132 + 32 * vb + l31] = o[r];
    }
    __syncthreads();
    {
        const LAS float* OT = (const LAS float*)(L + HC_OT);
        const int t = tid >> 3, vc = (tid & 7) * 16; const size_t row = (size_t)row0 + t;
        f32x4 x[4]; float ss = 0.f;
#pragma unroll
        for (int q = 0; q < 4; ++q) { x[q] = *(const LAS f32x4*)(OT + t * 132 + vc + 4 * q); ss += (x[q][0] * x[q][0] + x[q][1] * x[q][1]) + (x[q][2] * x[q][2] + x[q][3] * x[q][3]); }
        ss += __shfl_xor(ss, 1); ss += __shfl_xor(ss, 2); ss += __shfl_xor(ss, 4);
        const float rstd = 1.0f / sqrtf(ss * (1.0f / 128.0f) + EPS);
        const bf16* GB = (const bf16*)(F.ws + WS_GB); bf16* OB = (bf16*)((unsigned char*)F.out + DO_OB); const float* gn = F.in[10];
        const v4u g0 = *(const v4u*)(GB + row * 512 + 128 * h + vc), g1 = *(const v4u*)(GB + row * 512 + 128 * h + vc + 8);
        const float gg[16] = {bflo(g0.x), bfhi(g0.x), bflo(g0.y), bfhi(g0.y), bflo(g0.z), bfhi(g0.z), bflo(g0.w), bfhi(g0.w), bflo(g1.x), bfhi(g1.x), bflo(g1.y), bfhi(g1.y), bflo(g1.z), bfhi(g1.z), bflo(g1.w), bfhi(g1.w)};
        float y[16];
#pragma unroll
        for (int q = 0; q < 4; ++q)
#pragma unroll
            for (int j = 0; j < 4; ++j) y[4 * q + j] = x[q][j] * rstd * gn[vc + 4 * q + j] * gg[4 * q + j];
        v4u w0, w1; w0.x = pk2(y[0], y[1]); w0.y = pk2(y[2], y[3]); w0.z = pk2(y[4], y[5]); w0.w = pk2(y[6], y[7]); w1.x = pk2(y[8], y[9]); w1.y = pk2(y[10], y[11]); w1.z = pk2(y[12], y[13]); w1.w = pk2(y[14], y[15]);
        *(v4u*)(OB + row * 512 + 128 * h + vc) = w0; *(v4u*)(OB + row * 512 + 128 * h + vc + 8) = w1;
    }
    __syncthreads();
}


constexpr size_t WS_RS1S = WS_RS1 + 2560 * 1024, WS_RS2S = WS_RS2 + 2560 * 1024;
template <int KS, int K>
__device__ __forceinline__ void sk_partial(f32x4 (&acc)[8][2], const bf16* A, const bf16* Bt, int c0, int wave, int fr, int fq) {
    const int k0 = wave * KS * 32 + 8 * fq;
    const bf16* ap = A + (size_t)fr * K + k0;
    const bf16* bp0 = Bt + (size_t)(c0 + pg8::perm32(fr)) * K + k0;
    const bf16* bp1 = Bt + (size_t)(c0 + pg8::perm32(16 + fr)) * K + k0;
#pragma unroll
    for (int m = 0; m < 8; ++m) { acc[m][0] = (f32x4){0.f, 0.f, 0.f, 0.f}; acc[m][1] = (f32x4){0.f, 0.f, 0.f, 0.f}; }
#define SK_STEP(kt) do { const bf16x8 b0 = *(const bf16x8*)(bp0 + 32 * (kt)), b1 = *(const bf16x8*)(bp1 + 32 * (kt)); bf16x8 a[8]; \
        _Pragma("unroll") for (int m = 0; m < 8; ++m) a[m] = *(const bf16x8*)(ap + (size_t)16 * m * K + 32 * (kt)); \
        _Pragma("unroll") for (int m = 0; m < 8; ++m) { acc[m][0] = __builtin_amdgcn_mfma_f32_16x16x32_bf16(b0, a[m], acc[m][0], 0, 0, 0); acc[m][1] = __builtin_amdgcn_mfma_f32_16x16x32_bf16(b1, a[m], acc[m][1], 0, 0, 0); } } while (0)
    if (KS <= 4) {
#pragma unroll
        for (int kt = 0; kt < KS; ++kt) SK_STEP(kt);
    } else {
#pragma unroll 1
        for (int kt = 0; kt + 1 < KS; kt += 2) { SK_STEP(kt); SK_STEP(kt + 1); }
        if (KS & 1) SK_STEP(KS - 1);
    }
#undef SK_STEP
}
__device__ __forceinline__ void sk_reduce(LAS unsigned char* L, const f32x4 (&acc)[8][2], int wave, int lane, f32x4& r0, f32x4& r1) {
#pragma unroll
    for (int m = 0; m < 8; ++m) { *(LAS f32x4*)(L + (((wave * 8 + m) * 2 + 0) * 64 + lane) * 16) = acc[m][0]; *(LAS f32x4*)(L + (((wave * 8 + m) * 2 + 1) * 64 + lane) * 16) = acc[m][1]; }
    __syncthreads();
    r0 = (f32x4){0.f, 0.f, 0.f, 0.f}; r1 = (f32x4){0.f, 0.f, 0.f, 0.f};
#pragma unroll
    for (int ws = 0; ws < 8; ++ws) { r0 += *(const LAS f32x4*)(L + (((ws * 8 + wave) * 2 + 0) * 64 + lane) * 16); r1 += *(const LAS f32x4*)(L + (((ws * 8 + wave) * 2 + 1) * 64 + lane) * 16); }
    __syncthreads();
}
#define SK_WG_TASKS(t, n) for (int t = F.vcu; t < (n); t += F.G)
__device__ __forceinline__ v4u pack8(const f32x4 v0, const f32x4 v1) { v4u w; w.x = pk2(v0[0], v0[1]); w.y = pk2(v0[2], v0[3]); w.z = pk2(v1[0], v1[1]); w.w = pk2(v1[2], v1[3]); return w; }
__device__ __forceinline__ void unpack8(const v4u w, float (&f)[8]) { f[0] = bflo(w.x); f[1] = bfhi(w.x); f[2] = bflo(w.y); f[3] = bfhi(w.y); f[4] = bflo(w.z); f[5] = bfhi(w.z); f[6] = bflo(w.w); f[7] = bfhi(w.w); }
__device__ __forceinline__ void sk_in_group(unsigned char* ws, const float* lbl, float* out, int r, int gcol, f32x4 v0, f32x4 v1) {
    const int row = MP + r;
    if (gcol >= 2048 && gcol < 2560) {
        const int cs = gcol - 2048; f32x4 o0, o1;
#pragma unroll
        for (int j = 0; j < 4; ++j) { const float lb0 = __builtin_amdgcn_rcpf(1.0f + fast_exp(lbl[512 + cs + j] - lbl[cs + j])), lb1 = __builtin_amdgcn_rcpf(1.0f + fast_exp(lbl[512 + cs + 4 + j] - lbl[cs + 4 + j]));
            o0[j] = __builtin_amdgcn_logf(lb0 + (1.0f - lb0) * fast_sigmoid(v0[j])) * LN2; o1[j] = __builtin_amdgcn_logf(lb1 + (1.0f - lb1) * fast_sigmoid(v1[j])) * LN2; }
        float* p = (float*)(ws + WS_LF) + (size_t)row * 512 + cs; *(f32x4*)p = o0; *(f32x4*)(p + 4) = o1; return;
    }
    bf16* dst; int ld, act, cs, kv = 0;
    if (gcol < 512) { dst = (bf16*)(ws + WS_QA); ld = 512; act = 1; cs = gcol; }
    else if (gcol < 1024) { dst = (bf16*)(ws + WS_KA); ld = 512; act = 0; cs = gcol - 512; kv = 1; }
    else if (gcol < 1536) { dst = (bf16*)(ws + WS_VA); ld = 512; act = 0; cs = gcol - 1024; kv = 2; }
    else if (gcol < 2048) { dst = (bf16*)(ws + WS_QB); ld = 512; act = 2; cs = gcol - 1536; }
    else if (gcol < 3072) { dst = (bf16*)(ws + WS_VB); ld = 512; act = 0; cs = gcol - 2560; }
    else if (gcol < 3584) { dst = (bf16*)(ws + WS_GB); ld = 512; act = 2; cs = gcol - 3072; }
    else if (gcol < 4608) { dst = (bf16*)(ws + WS_ZA); ld = 1024; act = 3; cs = gcol - 3584; }
    else { dst = (bf16*)(ws + WS_ZB); ld = 1024; act = 3; cs = gcol - 4608; }
    if (act == 1) { v0 = v0 * QSCALE; v1 = v1 * QSCALE; }
    else if (act >= 2) {
#pragma unroll
        for (int j = 0; j < 4; ++j) { const float s0 = fast_sigmoid(v0[j]), s1 = fast_sigmoid(v1[j]); v0[j] = (act == 2) ? v0[j] * s0 : s0; v1[j] = (act == 2) ? v1[j] * s1 : s1; } }
    *(v4u*)(dst + (size_t)row * ld + cs) = pack8(v0, v1);
    if (kv) { const int hh = cs >> 6, d = cs & 63, bs = r >> 4, ts = r & 15; float* o = out + (kv == 1 ? O_KS : O_VS) + ((size_t)(bs * 8 + hh) * 16 + ts) * 64 + d; *(f32x4*)o = v0; *(f32x4*)(o + 4) = v1; }
}
__device__ __forceinline__ void sk_gemm1(Frame& F) {
    const int fr = F.lane & 15, fq = F.lane >> 4, m = F.wave;
    SK_WG_TASKS(t, DIN / 32) { f32x4 acc[8][2], r0, r1;
        sk_partial<4, 1024>(acc, (const bf16*)(F.ws + WS_H) + (size_t)MP * 1024, (const bf16*)(F.ws + WS_WIN), 32 * t, F.wave, fr, fq);
        sk_reduce(F.lds, acc, F.wave, F.lane, r0, r1);
        sk_in_group(F.ws, F.in[9], F.out, 16 * m + fr, 32 * t + 8 * fq, r0, r1); }
}
__device__ __forceinline__ void sk_merge(Frame& F) {
    const int fr = F.lane & 15, fq = F.lane >> 4, m = F.wave;
    const bf16* ZA = (const bf16*)(F.ws + WS_ZA); const bf16* ZB = (const bf16*)(F.ws + WS_ZB); bf16* MG = (bf16*)(F.ws + WS_MG);
    SK_WG_TASKS(t, DM / 32) { f32x4 acc[8][2], a0, a1, b0, b1;
        sk_partial<2, 512>(acc, (const bf16*)((const unsigned char*)F.out + DO_OA) + (size_t)MP * 512, (const bf16*)(F.ws + WS_WA), 32 * t, F.wave, fr, fq);
        sk_reduce(F.lds, acc, F.wave, F.lane, a0, a1);
        sk_partial<2, 512>(acc, (const bf16*)((const unsigned char*)F.out + DO_OB) + (size_t)MP * 512, (const bf16*)(F.ws + WS_WB), 32 * t, F.wave, fr, fq);
        sk_reduce(F.lds, acc, F.wave, F.lane, b0, b1);
        const size_t off = (size_t)(MP + 16 * m + fr) * 1024 + 32 * t + 8 * fq; float ga[8], gb[8]; unpack8(*(const v4u*)(ZA + off), ga); unpack8(*(const v4u*)(ZB + off), gb);
        f32x4 v0, v1;
#pragma unroll
        for (int j = 0; j < 4; ++j) { v0[j] = ga[j] * a0[j] + gb[j] * b0[j]; v1[j] = ga[4 + j] * a1[j] + gb[4 + j] * b1[j]; }
        *(v4u*)(MG + off) = pack8(v0, v1); }
}
template <bool DOWN>
__device__ __forceinline__ void sk_res(Frame& F) {
    const int fr = F.lane & 15, fq = F.lane >> 4, m = F.wave;
    float* RS = (float*)(F.ws + (DOWN ? WS_RS2S : WS_RS1S)); bf16* X1B = (bf16*)(F.ws + WS_X1B);
    SK_WG_TASKS(t, DM / 32) { f32x4 acc[8][2], r0, r1;
        if (DOWN) sk_partial<11, DFF>(acc, (const bf16*)(F.ws + WS_G) + (size_t)MP * DFF, (const bf16*)(F.ws + WS_WD), 32 * t, F.wave, fr, fq);
        else sk_partial<4, 1024>(acc, (const bf16*)(F.ws + WS_MG) + (size_t)MP * 1024, (const bf16*)(F.ws + WS_WOUT), 32 * t, F.wave, fr, fq);
        sk_reduce(F.lds, acc, F.wave, F.lane, r0, r1);
        const int r = 16 * m + fr, col = 32 * t + 8 * fq;
        const float* src = DOWN ? F.out + (size_t)(MP + r) * DM + col : F.in[1] + (size_t)r * DM + col;
        const f32x4 v0 = r0 + *(const f32x4*)src, v1 = r1 + *(const f32x4*)(src + 4);
        float* o = F.out + (size_t)(MP + r) * DM + col; *(f32x4*)o = v0; *(f32x4*)(o + 4) = v1;
        if (!DOWN) *(v4u*)(X1B + (size_t)(MP + r) * DM + col) = pack8(v0, v1);
        float ss = (v0[0] * v0[0] + v0[1] * v0[1]) + (v0[2] * v0[2] + v0[3] * v0[3]) + (v1[0] * v1[0] + v1[1] * v1[1]) + (v1[2] * v1[2] + v1[3] * v1[3]);
        ss += __shfl_xor(ss, 16); ss += __shfl_xor(ss, 32);
        if (fq == 0) RS[r * 32 + t] = ss; }
}
__device__ __forceinline__ float sk_rstd(const float* RS, int r) {
    const f32x4* p = (const f32x4*)(RS + r * 32); float s = 0.f;
#pragma unroll
    for (int i = 0; i < 8; ++i) { const f32x4 a = p[i]; s += (a[0] + a[1]) + (a[2] + a[3]); }
    return 1.0f / sqrtf(s * (1.0f / DM) + EPS);
}
__device__ __forceinline__ void sk_gu(Frame& F) {
    const int lane = F.lane, fr = lane & 15, fq = lane >> 4, m = F.wave;
    const float* RS = (const float*)(F.ws + WS_RS1S); bf16* G = (bf16*)(F.ws + WS_G); const float* cw = F.in[17]; const float* cb = F.in[18]; const float* st = F.in[5];
    const bf16* A = (const bf16*)(F.ws + WS_X1B) + (size_t)MP * 1024; const bf16* Bt = (const bf16*)(F.ws + WS_WGU);
    const int src1 = (lane & 48) | ((fr - 1) & 15), src2 = (lane & 48) | ((fr - 2) & 15);
    SK_WG_TASKS(t, DFF / 32) {
        const int pn = t >> 2, jj0 = 32 * (t & 3), c0g = 256 * pn + jj0, nbase = 128 * pn + jj0 + 8 * fq;
        f32x4 acc[8][2], g0, g1, u0, u1;
        sk_partial<4, 1024>(acc, A, Bt, c0g, F.wave, fr, fq);
        sk_reduce(F.lds, acc, F.wave, F.lane, g0, g1);
        sk_partial<4, 1024>(acc, A, Bt, c0g + 128, F.wave, fr, fq);
        sk_reduce(F.lds, acc, F.wave, F.lane, u0, u1);
        const int r = 16 * m + fr; const float rs = sk_rstd(RS, r);
#pragma unroll
        for (int n = 0; n < 2; ++n) { const int nc = nbase + 4 * n;
            const f32x4 cbv = *(const f32x4*)(cb + nc), c0 = *(const f32x4*)(cw + nc), c1 = *(const f32x4*)(cw + DFF + nc), c2 = *(const f32x4*)(cw + 2 * DFF + nc);
            const f32x4 s0 = *(const f32x4*)(st + ((size_t)m * 2 + 0) * DFF + nc), s1 = *(const f32x4*)(st + ((size_t)m * 2 + 1) * DFF + nc);
            const f32x4 a = (n ? g1 : g0) * rs, uu = (n ? u1 : u0) * rs; f32x4 g;
#pragma unroll
            for (int j = 0; j < 4; ++j) { const float t1 = __shfl(a[j], src1), tt2 = __shfl(a[j], src2);
                const float p1 = fr >= 1 ? t1 : s1[j], p2 = fr >= 2 ? tt2 : (fr == 1 ? s1[j] : s0[j]);
                g[j] = gelu_tanh(cbv[j] + c0[j] * p2 + c1[j] * p1 + c2[j] * a[j]) * uu[j]; }
            *(unsigned long long*)(G + (size_t)(MP + r) * DFF + nc) = (unsigned long long)pk2(g[0], g[1]) | ((unsigned long long)pk2(g[2], g[3]) << 32);
            if (fr >= DSEQ - 2) *(f32x4*)(F.out + O_CS + ((size_t)m * 2 + (fr - (DSEQ - 2))) * DFF + nc) = a; } }
}

__device__ __forceinline__ void conv_phase(Frame& F) {
    bf16* G = (bf16*)(F.ws + WS_G); const float* ST = (const float*)(F.ws + WS_ST);
    const float* cw = F.in[17]; const float* cb = F.in[18]; const float* st = F.in[5];
    const int gt = F.vcu * 512 + F.tid, NT = F.G * 512;
    constexpr int CPR = DFF / 8;
    for (int it = gt; it < 512 * 2 * CPR; it += NT) {
        const int c8 = (it % CPR) * 8, sj = it / CPR, sp = sj >> 1, j = sj & 1; const bool first = (sp & 255) == 0;
        const float* B = ST + (size_t)sp * 6 * DFF + c8; const float* P = ST + (size_t)(sp - 1) * 6 * DFF + c8;
        float g[8];
#pragma unroll
        for (int q = 0; q < 8; ++q) {
            const float a2 = B[(size_t)j * DFF + q], uu = B[(size_t)(2 + j) * DFF + q];
            const float a1 = j ? B[q] : (first ? 0.f : P[(size_t)5 * DFF + q]);
            const float a0 = first ? 0.f : (j ? P[(size_t)5 * DFF + q] : P[(size_t)4 * DFF + q]);
            g[q] = gelu_tanh(cb[c8 + q] + cw[c8 + q] * a0 + cw[DFF + c8 + q] * a1 + cw[2 * DFF + c8 + q] * a2) * uu;
        }
        v4u w; w.x = pk2(g[0], g[1]); w.y = pk2(g[2], g[3]); w.z = pk2(g[4], g[5]); w.w = pk2(g[6], g[7]);
        *(v4u*)(G + (size_t)(64 * sp + j) * DFF + c8) = w;
    }
}
__device__ __forceinline__ void final_norm_phase(Frame& F) {
    const float* RS = (const float*)(F.ws + WS_RS2); const float* g = F.in[20];
    const int gw = F.vcu * NWAVES + F.wave, NGW = F.G * NWAVES;
    for (int m = gw; m < MV; m += NGW) {
        const float rs = m < MP ? row_rstd(RS, m) : sk_rstd((const float*)(F.ws + WS_RS2S), m - MP);
        GAS f32x4* xr = (GAS f32x4*)(F.out + (size_t)m * DM) + F.lane;
#pragma unroll
        for (int j = 0; j < 4; ++j) { const f32x4 gg = ((const GAS f32x4*)g)[F.lane + 64 * j]; f32x4 v = xr[64 * j]; v = v * rs * gg; xr[64 * j] = v; }
    }
}

constexpr int N_PHASES = 11;
__global__ void __launch_bounds__(NWAVES * 64, 2) mk_fwd(Args args) {
    extern __shared__ __attribute__((aligned(16))) unsigned char lds[];
    Frame F;
    F.lds = (LAS unsigned char*)lds;
    F.tid = threadIdx.x; F.lane = F.tid & 63; F.wave = __builtin_amdgcn_readfirstlane(F.tid >> 6);
    F.G = gridDim.x; { const int bx = blockIdx.x; F.vcu = (F.G % 8 == 0) ? (bx % 8) * (F.G / 8) + bx / 8 : bx; }
#pragma unroll
    for (int i = 0; i < 21; ++i) F.in[i] = args.in[i];
    F.out = args.out; F.ws = args.ws;
    for (int u = F.tid; u < (LDS_BYTES - LDSCTL_OFF) / 4; u += NWAVES * 64) ((LAS unsigned*)(F.lds + LDSCTL_OFF))[u] = 0u;
    __syncthreads();
    gu32* ctl = (gu32*)(F.ws + WS_CTL);
    XcdBarrier bar; bar.bar = (unsigned*)(ctl + CW_BAR); bar.x = 0; bar.st = nullptr;
    if (MK_N_LAUNCHES == 1) bar = xcd_barrier_post((unsigned*)(ctl + CW_BAR), (volatile LAS unsigned*)(F.lds + MISC_OFF) + 8);
    const int lo = args.ph_lo, hi = args.ph_hi;
#ifndef PHMASK
#define PHMASK 0xffff
#endif
#define IN(k) (((PHMASK >> (k)) & 1) && lo <= (k) && (k) < hi)
#define REP(k) for (int rep_ = 0; rep_ < ((PROBE_DUP == (k)) ? 2 : 1); ++rep_)
#define SEAM(k) do { if (IN(k) && IN((k) + 1)) xcd_barrier(bar); } while (0)

    if (IN(0)) REP(0) { p0_prologue(F); }
    SEAM(0);
    if (IN(1)) REP(1) {
        PlainSched S; S.T.init(MP / 256, DIN / 256); S.G = F.G; S.c = (int)blockIdx.x; S.A = (const char*)(F.ws + WS_H); S.Bt = (const char*)(F.ws + WS_WIN); S.tstep = (size_t)256 * 1024 * 2;
        EpiIn E{F.ws, F.in[9], F.out};
        pg8::gemm_phase(F.lds, 1024, S, E);
        sk_gemm1(F);
    }
    SEAM(1);
    if (IN(2)) REP(2) {
        for (int it = F.vcu; it < 2048; it += F.G) hgrn_passA_item(F, it);
        if (blockIdx.x < 32) { const int i = blockIdx.x, b = i >> 2, h = i & 3; hgrn_simple(F, MP + b * DSEQ, DSEQ, h, F.in[4] + (size_t)(b * 4 + h) * 16384, F.out + O_HS + (size_t)(b * 4 + h) * 16384); }
        const int gw = F.vcu * NWAVES + F.wave, NGW = F.G * NWAVES;
        for (int it = gw; it < MS * NHA; it += NGW) { const int qrow = MP + (it >> 3), h = it & 7; attn_simple_row<true>(F, qrow, h); }
        __syncthreads();
        for (int it = F.vcu; it < 1024; it += F.G) attn_unit(F, it);
    }
    SEAM(2);
    if (IN(3)) REP(3) { hgrn_scan(F); }
    SEAM(3);
    if (IN(4)) REP(4) { for (int it = F.vcu; it < 2048; it += F.G) hgrn_passC_item(F, it); }
    SEAM(4);
    if (IN(5)) REP(5) {
        MergeSched S; S.T.init(MP / 256, DM / 256); S.G = F.G; S.c = (int)blockIdx.x; S.A0 = (const char*)F.out + DO_OA; S.A1 = (const char*)F.out + DO_OB;
        S.B0 = (const char*)(F.ws + WS_WA); S.B1 = (const char*)(F.ws + WS_WB); S.tstep = (size_t)256 * 512 * 2;
        EpiMerge E{(const bf16*)(F.ws + WS_ZA), (const bf16*)(F.ws + WS_ZB), (bf16*)(F.ws + WS_MG)};
        pg8::gemm_phase(F.lds, 512, S, E);
        sk_merge(F);
    }
    SEAM(5);
    if (IN(6)) REP(6) {
        PlainSched S; S.T.init(MP / 256, DM / 256); S.G = F.G; S.c = (int)blockIdx.x; S.A = (const char*)(F.ws + WS_MG); S.Bt = (const char*)(F.ws + WS_WOUT); S.tstep = (size_t)256 * 1024 * 2;
        EpiRes<false> E{F.in[0], F.in[1], F.out, (bf16*)(F.ws + WS_X1B), (float*)(F.ws + WS_RS1)};
        pg8::gemm_phase(F.lds, 1024, S, E);
        sk_res<false>(F);
    }
    SEAM(6);
    if (IN(7)) REP(7) {
        PlainSched S; S.T.init(MP / 256, DIN / 256); S.G = F.G; S.c = (int)blockIdx.x; S.A = (const char*)(F.ws + WS_X1B); S.Bt = (const char*)(F.ws + WS_WGU); S.tstep = (size_t)256 * 1024 * 2;
        LAS float* rstdL = (LAS float*)(F.lds + RING_BYTES);
        { Unit u; for (int i = 0; S.next(i, u); ++i) for (int r = F.tid; r < 256; r += NWAVES * 64) rstdL[i * 256 + r] = row_rstd((const float*)(F.ws + WS_RS1), u.pm * 256 + r); }
        __syncthreads();
        EpiGU E{rstdL, (bf16*)(F.ws + WS_G), (float*)(F.ws + WS_ST), F.in[17], F.in[18], F.out};
        pg8::gemm_phase(F.lds, 1024, S, E);
        sk_gu(F);
    }
    SEAM(7);
    if (IN(8)) { conv_phase(F); }
    SEAM(8);
    if (IN(9)) {
        PlainSched S; S.T.init(MP / 256, DM / 256); S.G = F.G; S.c = (int)blockIdx.x; S.A = (const char*)(F.ws + WS_G); S.Bt = (const char*)(F.ws + WS_WD); S.tstep = (size_t)256 * DFF * 2;
        EpiRes<true> E{nullptr, nullptr, F.out, nullptr, (float*)(F.ws + WS_RS2)};
        pg8::gemm_phase(F.lds, DFF, S, E);
        sk_res<true>(F);
    }
    SEAM(9);
    if (IN(10)) { final_norm_phase(F); }
#undef IN
#undef SEAM
}

extern "C" void kernel_launch(void* const* d_in, const int* in_sizes, int n_in, void* d_out, int out_size, void* d_ws, size_t ws_size, hipStream_t stream) {
    static int grid = 0;
    if (grid == 0) {
        if (n_in != 21 || out_size != (int)O_END || ws_size < WS_END) { fprintf(stderr, "kernel_launch: unexpected shapes: n_in %d out %d ws %zu (need %zu)\n", n_in, out_size, ws_size, (size_t)WS_END); grid = -1; return; }
        int dev = 0, cus = 0, per_cu = 0;
        if (hipGetDevice(&dev) != hipSuccess || hipDeviceGetAttribute(&cus, hipDeviceAttributeMultiprocessorCount, dev) != hipSuccess) { grid = -1; return; }
        if (hipFuncSetAttribute((const void*)mk_fwd, hipFuncAttributeMaxDynamicSharedMemorySize, LDS_BYTES) != hipSuccess) { fprintf(stderr, "kernel_launch: hipFuncSetAttribute failed\n"); grid = -1; return; }
        if (hipOccupancyMaxActiveBlocksPerMultiprocessor(&per_cu, (const void*)mk_fwd, NWAVES * 64, LDS_BYTES) != hipSuccess || per_cu < 1) fprintf(stderr, "kernel_launch: occupancy query says %d\n", per_cu);
        (void)hipGetLastError();
        grid = cus;
    }
    if (grid < 0) return;
    (void)hipMemsetAsync((char*)d_ws + WS_CTL, 0, CTL_ZERO_BYTES, stream);
    Args a{};
    for (int i = 0; i < 21; ++i) a.in[i] = (const float*)d_in[i];
    a.out = (float*)d_out; a.ws = (unsigned char*)d_ws;
    if (MK_N_LAUNCHES == 1) { a.ph_lo = 0; a.ph_hi = N_PHASES; hipLaunchKernelGGL(mk_fwd, dim3(grid), dim3(NWAVES * 64), LDS_BYTES, stream, a); }
    else { for (int p = 0; p < N_PHASES; ++p) { a.ph_lo = p; a.ph_hi = p + 1; hipLaunchKernelGGL(mk_fwd, dim3(grid), dim3(NWAVES * 64), LDS_BYTES, stream, a); } }
}
```
